# Optimizing an MI355X kernel written in HIP

```python
import jax, jax.numpy as jnp
from jax import lax
import numpy as np

D_MODEL = 1024
BATCH = 8
SEQ = 2048
DEPTH = 1
DEC_BATCH = 128
DEC_SEQ = 1
PAST_LEN = 16384
PAGE_SIZE = 128

RET_DK = 256
RET_HEADS = D_MODEL // 256
RET_DV = 2 * RET_DK
RET_QK = RET_HEADS * RET_DK
RET_V = RET_HEADS * RET_DV
RET_CHUNK = 128
ROPE_BASE = 10000.0
GM_GROUPS = 4
GM_WIDTH = D_MODEL
GM_CG = GM_WIDTH // GM_GROUPS
GM_CHUNK = 128
D_FF = ((8 * D_MODEL // 3 + 255) // 256) * 256
EPS = 1e-6
D_IN = 2 * RET_QK + 2 * RET_V + 2 * GM_WIDTH + 2 * D_MODEL
SPLIT_IDX = (
    RET_QK,
    2 * RET_QK,
    2 * RET_QK + RET_V,
    2 * RET_QK + 2 * RET_V,
    2 * RET_QK + 2 * RET_V + GM_WIDTH,
    2 * RET_QK + 2 * RET_V + 2 * GM_WIDTH,
    2 * RET_QK + 2 * RET_V + 2 * GM_WIDTH + D_MODEL,
)

kernel_name = "retention_gmlp_hybrid_step"


def rms_norm(x, g):
    xf = x.astype(jnp.float32)
    y = xf * lax.rsqrt(jnp.mean(xf * xf, axis=-1, keepdims=True) + EPS)
    return (y * g.astype(jnp.float32)).astype(x.dtype)


def head_rms(x):
    xf = x.astype(jnp.float32)
    return xf * lax.rsqrt(jnp.mean(xf * xf, axis=-1, keepdims=True) + EPS)


def layer_norm(x, g, b):
    xf = x.astype(jnp.float32)
    mu = jnp.mean(xf, axis=-1, keepdims=True)
    xc = xf - mu
    y = xc * lax.rsqrt(jnp.mean(xc * xc, axis=-1, keepdims=True) + EPS)
    return (y * g.astype(jnp.float32) + b.astype(jnp.float32)).astype(x.dtype)


def rotary(x, pos):
    half = x.shape[-1] // 2
    inv = ROPE_BASE ** (-jnp.arange(half, dtype=jnp.float32) / half)
    ang = pos[:, None] * inv[None, :]
    cos = jnp.cos(ang)[None, :, None, :]
    sin = jnp.sin(ang)[None, :, None, :]
    x1 = x[..., :half].astype(jnp.float32)
    x2 = x[..., half:].astype(jnp.float32)
    return jnp.concatenate([x1 * cos - x2 * sin, x1 * sin + x2 * cos], axis=-1)


def retention(q, k, v, state0):
    B, T, H, DK = q.shape
    DV = v.shape[-1]
    L = min(T, RET_CHUNK)
    nc = T // L
    lg = jnp.log1p(-jnp.exp2(-5.0 - jnp.arange(H, dtype=jnp.float32)))
    n = jnp.arange(L, dtype=jnp.float32)
    diff = n[:, None] - n[None, :]
    intra_decay = jnp.where(diff[None] >= 0,
                            jnp.exp(jnp.maximum(diff, 0.0)[None] * lg[:, None, None]), 0.0)
    q_decay = jnp.exp((n + 1.0)[:, None] * lg[None, :])[None, :, :, None]
    k_decay = jnp.exp((L - 1.0 - n)[:, None] * lg[None, :])[None, :, :, None]
    chunk_decay = jnp.exp(L * lg)[None, :, None, None]

    def to_chunks(a):
        return a.reshape(B, nc, L, H, a.shape[-1]).transpose(1, 0, 2, 3, 4)

    def step(state, qkv):
        qc, kc, vc = qkv
        scores = jnp.einsum('bthd,bshd->bhts', qc, kc) * intra_decay[None]
        o = (jnp.einsum('bhts,bshv->bthv', scores, vc)
             + jnp.einsum('bthd,bhdv->bthv', qc, state) * q_decay)
        new_state = chunk_decay * state + jnp.einsum('bthd,bthv->bhdv', kc * k_decay, vc)
        return new_state, o

    state, o = lax.scan(step, state0, (to_chunks(q), to_chunks(k), to_chunks(v)))
    o = o.transpose(1, 0, 2, 3, 4).reshape(B, T, H, DV)
    return o, state


def chunk_gmlp(u, v, gm_ws, gm_bs):
    B, T, _ = v.shape
    L = min(T, GM_CHUNK)
    nc = T // L
    vc = v.reshape(B, nc, L, GM_GROUPS, GM_CG)
    ws = jnp.tril(gm_ws[:, :L, :L])
    bias = gm_bs[:, :L].T[None, None, :, :, None]
    mixed = jnp.einsum('gts,bnsgc->bntgc', ws, vc) + bias
    return u * mixed.reshape(B, T, GM_WIDTH)


def hybrid_layer(x, ret_state0, pos, norm_mix_g, w_in, w_ret_o, gm_ln_g, gm_ln_b,
                 gm_ws, gm_bs, w_gm_o, w_o, norm_ffn_g, w_ffn_in, w_ffn_down):
    B, T, _ = x.shape
    xn = rms_norm(x, norm_mix_g)
    z = xn @ w_in
    q, k, v, g, gu, gv, a_ret, a_gm = jnp.split(z, SPLIT_IDX, axis=-1)

    q = rotary(q.reshape(B, T, RET_HEADS, RET_DK), pos)
    k = rotary(k.reshape(B, T, RET_HEADS, RET_DK), pos) * (RET_DK ** -0.5)
    v = v.reshape(B, T, RET_HEADS, RET_DV).astype(jnp.float32)
    o, new_state = retention(q, k, v, ret_state0.astype(jnp.float32))
    o = head_rms(o).reshape(B, T, RET_V)
    branch_ret = (jax.nn.silu(g.astype(jnp.float32)) * o).astype(x.dtype) @ w_ret_o

    gu = jax.nn.gelu(gu)
    gv = layer_norm(jax.nn.gelu(gv), gm_ln_g, gm_ln_b)
    branch_gm = chunk_gmlp(gu, gv, gm_ws, gm_bs) @ w_gm_o

    m = jax.nn.sigmoid(a_ret) * branch_ret + jax.nn.sigmoid(a_gm) * branch_gm
    h = x + (m @ w_o).astype(x.dtype)

    hn = rms_norm(h, norm_ffn_g)
    f_gate, f_up = jnp.split(hn @ w_ffn_in, 2, axis=-1)
    h = h + ((jax.nn.silu(f_gate) * f_up) @ w_ffn_down).astype(x.dtype)
    return h, new_state, gv


def setup_inputs(seed: int = 0) -> dict:
    key = jax.random.key(seed)
    ks = jax.random.split(key, 20)
    nrm = lambda k, shape, s: jax.random.normal(k, shape, jnp.float32) * s
    return {
        "x_prompt": nrm(ks[0], (BATCH, SEQ, D_MODEL), 1.0),
        "x_sample": nrm(ks[1], (DEC_BATCH, DEC_SEQ, D_MODEL), 1.0),
        "state_ret": nrm(ks[2], (DEPTH, DEC_BATCH, RET_HEADS, RET_DK, RET_DV), 0.5),
        "norm_mix_g": 1.0 + nrm(ks[3], (DEPTH, D_MODEL), 0.05),
        "w_in": nrm(ks[4], (DEPTH, D_MODEL, D_IN), D_MODEL ** -0.5),
        "w_ret_o": nrm(ks[5], (DEPTH, RET_V, D_MODEL), RET_V ** -0.5),
        "gm_ln_g": 1.0 + nrm(ks[6], (DEPTH, GM_WIDTH), 0.05),
        "gm_ln_b": nrm(ks[7], (DEPTH, GM_WIDTH), 0.02),
        "gm_ws": nrm(ks[8], (DEPTH, GM_GROUPS, GM_CHUNK, GM_CHUNK), GM_CHUNK ** -0.5),
        "gm_bs": 1.0 + nrm(ks[9], (DEPTH, GM_GROUPS, GM_CHUNK), 0.1),
        "w_gm_o": nrm(ks[10], (DEPTH, GM_WIDTH, D_MODEL), GM_WIDTH ** -0.5),
        "w_o": nrm(ks[11], (DEPTH, D_MODEL, D_MODEL), D_MODEL ** -0.5),
        "norm_ffn_g": 1.0 + nrm(ks[12], (DEPTH, D_MODEL), 0.05),
        "w_ffn_in": nrm(ks[13], (DEPTH, D_MODEL, 2 * D_FF), D_MODEL ** -0.5),
        "w_ffn_down": nrm(ks[14], (DEPTH, D_FF, D_MODEL), D_FF ** -0.5),
        "norm_final_g": 1.0 + nrm(ks[15], (D_MODEL,), 0.05),
    }


def reference(x_prompt, x_sample, state_ret, norm_mix_g, w_in, w_ret_o, gm_ln_g, gm_ln_b,
              gm_ws, gm_bs, w_gm_o, w_o, norm_ffn_g, w_ffn_in, w_ffn_down, norm_final_g):
    pos_prompt = jnp.arange(SEQ, dtype=jnp.float32)
    pos_sample = PAST_LEN + jnp.arange(DEC_SEQ, dtype=jnp.float32)
    hp, hs = x_prompt, x_sample
    ret_p, ret_s, gmv_s = [], [], []
    for l in range(DEPTH):
        w = (norm_mix_g[l], w_in[l], w_ret_o[l], gm_ln_g[l], gm_ln_b[l], gm_ws[l], gm_bs[l],
             w_gm_o[l], w_o[l], norm_ffn_g[l], w_ffn_in[l], w_ffn_down[l])
        zero_state = jnp.zeros((BATCH, RET_HEADS, RET_DK, RET_DV), jnp.float32)
        hp, sp, _ = hybrid_layer(hp, zero_state, pos_prompt, *w)
        hs, ss, vs = hybrid_layer(hs, state_ret[l], pos_sample, *w)
        ret_p.append(sp)
        ret_s.append(ss)
        gmv_s.append(vs)
    y_prompt = rms_norm(hp, norm_final_g)
    y_sample = rms_norm(hs, norm_final_g)
    ret_state_prompt = jnp.stack(ret_p)
    ret_state_sample = jnp.stack(ret_s)
    gm_v_sample = jnp.stack(gmv_s)
    return (y_prompt, y_sample, ret_state_prompt, ret_state_sample, gm_v_sample)
```

```cpp
#include <hip/hip_runtime.h>
#include <hip/hip_cooperative_groups.h>
#include <cstdio>
namespace cg = cooperative_groups;

#define LAS __attribute__((address_space(3)))
#define DI __device__ __forceinline__
typedef unsigned short bf16_t;
typedef short bf16x8 __attribute__((ext_vector_type(8)));
typedef float f32x4 __attribute__((ext_vector_type(4)));
typedef float f32x2 __attribute__((ext_vector_type(2)));
typedef float f32x16 __attribute__((ext_vector_type(16)));
typedef unsigned u32x4 __attribute__((ext_vector_type(4)));
typedef unsigned u32x2 __attribute__((ext_vector_type(2)));
typedef LAS unsigned char* ldsp;

constexpr int NP = 16384, NSAMP = 128, MR = NP + NSAMP, MP = 16640;
constexpr int LDS_BYTES = 147456;
constexpr float EPSF = 1e-6f;

constexpr size_t SZ_MP1024_BF = (size_t)MP * 1024 * 2;
constexpr size_t OFF_XN = 0;
constexpr size_t OFF_WT1 = OFF_XN + SZ_MP1024_BF;
constexpr size_t OFF_WT2 = OFF_WT1 + (size_t)7168 * 1024 * 2;
constexpr size_t OFF_WRET = OFF_WT2 + (size_t)4096 * 1024 * 2;
constexpr size_t OFF_WGM = OFF_WRET + (size_t)1024 * 2048 * 2;
constexpr size_t OFF_WO = OFF_WGM + (size_t)1024 * 1024 * 2;
constexpr size_t OFF_WF1 = OFF_WO + (size_t)1024 * 1024 * 2;
constexpr size_t OFF_WF2 = OFF_WF1 + (size_t)5632 * 1024 * 2;
constexpr size_t OFF_Q = OFF_WF2 + (size_t)1024 * 2816 * 2;
constexpr size_t OFF_K = OFF_Q + SZ_MP1024_BF;
constexpr size_t OFF_SG = OFF_K + SZ_MP1024_BF;
constexpr size_t OFF_GU = OFF_SG + 2 * SZ_MP1024_BF;
constexpr size_t OFF_AR = OFF_GU + SZ_MP1024_BF;
constexpr size_t OFF_AG = OFF_AR + SZ_MP1024_BF;
constexpr size_t OFF_KT = OFF_AG + SZ_MP1024_BF;
constexpr size_t OFF_VT = OFF_KT + SZ_MP1024_BF;
constexpr size_t OFF_GVT = OFF_VT + 2 * SZ_MP1024_BF;
constexpr size_t OFF_RO = OFF_GVT + SZ_MP1024_BF;
constexpr size_t OFF_GI = OFF_RO + 2 * SZ_MP1024_BF;
constexpr size_t OFF_T1 = OFF_GI + SZ_MP1024_BF;
constexpr size_t OFF_MM = OFF_T1 + 2 * SZ_MP1024_BF;
constexpr size_t OFF_H = OFF_MM + SZ_MP1024_BF;
constexpr size_t OFF_HB = OFF_H + 2 * SZ_MP1024_BF;
constexpr size_t OFF_ACT = OFF_HB + SZ_MP1024_BF;
constexpr size_t OFF_ST = OFF_ACT + (size_t)MP * 2816 * 2;
constexpr size_t OFF_ROPE = OFF_ST + (size_t)MP * 8 * 4;
constexpr size_t WS_END = OFF_ROPE + (size_t)2049 * 128 * 8;

constexpr size_t OUT_Y = 0;
constexpr size_t OUT_SP = (size_t)MR * 1024;
constexpr size_t OUT_SS = OUT_SP + (size_t)8 * 4 * 256 * 512;
constexpr size_t OUT_GV = OUT_SS + (size_t)128 * 4 * 256 * 512;

struct Params {
    const float* in[16];
    float* out;
    unsigned char* ws;
};

DI unsigned cvt_pk_bf16(float lo, float hi) { unsigned r; asm("v_cvt_pk_bf16_f32 %0, %1, %2" : "=v"(r) : "v"(lo), "v"(hi)); return r; }
DI float bf_lo(unsigned v) { return __uint_as_float(v << 16); }
DI float bf_hi(unsigned v) { return __uint_as_float(v & 0xffff0000u); }
DI float bf2f(bf16_t b) { return __uint_as_float(((unsigned)b) << 16); }
DI bf16_t f2bf(float f) { return (bf16_t)(cvt_pk_bf16(f, 0.f) & 0xffffu); }
DI u32x4 pack8(const float* v) { u32x4 p; p[0] = cvt_pk_bf16(v[0], v[1]); p[1] = cvt_pk_bf16(v[2], v[3]); p[2] = cvt_pk_bf16(v[4], v[5]); p[3] = cvt_pk_bf16(v[6], v[7]); return p; }
DI void unpack8(u32x4 p, float* v) { v[0] = bf_lo(p[0]); v[1] = bf_hi(p[0]); v[2] = bf_lo(p[1]); v[3] = bf_hi(p[1]); v[4] = bf_lo(p[2]); v[5] = bf_hi(p[2]); v[6] = bf_lo(p[3]); v[7] = bf_hi(p[3]); }
DI float fsigmoid(float x) { return __builtin_amdgcn_rcpf(1.f + __expf(-x)); }
DI float fsilu(float x) { return x * fsigmoid(x); }
DI float fgelu(float x) { const float u = 0.7978845608028654f * (x + 0.044715f * x * x * x); return x * fsigmoid(2.f * u); }
DI int opaque_tid() { int t = threadIdx.x; asm volatile("" : "+v"(t)); return t; }
#define MFMA32(a, b, c) __builtin_amdgcn_mfma_f32_32x32x16_bf16((a), (b), (c), 0, 0, 0)

namespace pg8 {
constexpr int BM = 256, BK = 64, HALF = 128, HTB = HALF * BK * 2, STAGE_BYTES = 8 * HTB, NXCD = 8, WGM = 8;
DI int lds_byte(int r, int c) { const int st = (r >> 4) * 2 + (c >> 5), rr = r & 15, cc = c & 31, ob = rr * 64 + cc * 2; return st * 1024 + (ob ^ (((ob >> 9) & 1) << 5)); }
DI void stage_rc(int b, int& R, int& C) { const int st = b / 1024, sb = b % 1024, swz = sb ^ (((sb >> 9) & 1) << 5); R = (st >> 1) * 16 + swz / 64; C = (st & 1) * 32 + (swz % 64) / 2; }
DI int perm32(int rho) { const int n = rho >> 4, i = rho & 15; return 8 * (i >> 2) + 4 * n + (i & 3); }
struct Unit { int pm, pn; };
struct Gemm { const bf16_t* A; const bf16_t* Bt; int M, N, K; };
struct Order {
    int nM, nN, nwg, G, c;
    DI void init(int M, int N, int G_, int c_) { nM = M / BM; nN = N / BM; nwg = nM * nN; G = G_; c = c_; }
    DI bool next(int i, Unit& u) const {
        const long L = (long)i * G + c; if (L >= nwg) return false;
        int wgid = (int)L; { const int q = nwg / NXCD, r = nwg % NXCD, xcd = wgid % NXCD, off = wgid / NXCD; wgid = (xcd < r ? xcd * (q + 1) : r * (q + 1) + (xcd - r) * q) + off; }
        const int nig = WGM * nN, gid = wgid / nig, fm = gid * WGM, gsz = (nM - fm) < WGM ? (nM - fm) : WGM;
        u.pm = fm + ((wgid % nig) % gsz); u.pn = (wgid % nig) / gsz; return true;
    }
};

template <class Epi>
DI void gemm_phase(ldsp lds, const Gemm g, const Order& S, const Epi& E) {
    const int tid = opaque_tid(), wid = __builtin_amdgcn_readfirstlane(tid >> 6), lane = tid & 63, wr = wid >> 2, wc = wid & 3, fr = lane & 15, fq = lane >> 4;
    const int K = g.K, nt = K / BK;
    unsigned voffA[2], voffB[2];
#pragma unroll
    for (int i = 0; i < 2; ++i) { int R, C; stage_rc(tid * 16 + i * 8192, R, C); const int Rb = Epi::PERM ? ((R & ~31) + perm32(R & 31)) : R;
        voffA[i] = (unsigned)(R * K + C) * 2u; voffB[i] = (unsigned)(Rb * K + C) * 2u; }
    const size_t kstep = (size_t)(BK * 2);
    const size_t hstep = (size_t)HALF * K * 2;
    const size_t tstep = 2 * hstep;
    const unsigned ldsw = (unsigned)wid * 1024u;
    const int aoff = lds_byte(wr * 64 + fr, fq * 8), boff = lds_byte(wc * 32 + fr, fq * 8);
#define PG8_SA(b, h) (((b) * 2 + (h)) * HTB)
#define PG8_SB(b, h) ((4 + (b) * 2 + (h)) * HTB)
#define PG8_STAGE(bufoff, gbase, voff) do { _Pragma("unroll") for (int _i = 0; _i < 2; ++_i) \
        __builtin_amdgcn_global_load_lds((const unsigned*)((const char*)(gbase) + (voff)[_i]), (LAS unsigned*)(lds + (bufoff) + ldsw + _i * 8192), 16, 0, 0); } while (0)
#define PG8_LDA(dst, b, h) do { _Pragma("unroll") for (int m = 0; m < 4; ++m) _Pragma("unroll") for (int k = 0; k < 2; ++k) dst[m][k] = *(const LAS bf16x8*)(lds + PG8_SA(b, h) + aoff + m * 2048 + k * 1024); } while (0)
#define PG8_LDB(dst, b, h) do { _Pragma("unroll") for (int n = 0; n < 2; ++n) _Pragma("unroll") for (int k = 0; k < 2; ++k) dst[n][k] = *(const LAS bf16x8*)(lds + PG8_SB(b, h) + boff + n * 2048 + k * 1024); } while (0)
#define PG8_MMA(ai, bj, At, Bt) do { __builtin_amdgcn_s_setprio(1); _Pragma("unroll") for (int m = 0; m < 4; ++m) _Pragma("unroll") for (int n = 0; n < 2; ++n) _Pragma("unroll") for (int k = 0; k < 2; ++k) \
        acc[ai][bj][m][n] = __builtin_amdgcn_mfma_f32_16x16x32_bf16(Bt[n][k], At[m][k], acc[ai][bj][m][n], 0, 0, 0); __builtin_amdgcn_s_setprio(0); } while (0)
#define PG8_WAIT_V(n) asm volatile("s_waitcnt vmcnt(" #n ")" ::: "memory")
#define PG8_WAIT_L(n) asm volatile("s_waitcnt lgkmcnt(" #n ")" ::: "memory")
#define PG8_BAR __builtin_amdgcn_s_barrier()
#define PG8_SCHED __builtin_amdgcn_sched_barrier(0)
    Unit cur, nxt; int ui = 0;
    if (!S.next(0, cur)) return;
    f32x4 acc[2][2][4][2];
#pragma unroll
    for (int a = 0; a < 2; ++a)
#pragma unroll
        for (int b = 0; b < 2; ++b)
#pragma unroll
            for (int m = 0; m < 4; ++m)
#pragma unroll
                for (int n = 0; n < 2; ++n) acc[a][b][m][n] = (f32x4){0.f, 0.f, 0.f, 0.f};
    bf16x8 At[4][2], B0[2][2], B1[2][2];
    const char* cA = (const char*)g.A + (size_t)cur.pm * tstep; const char* cB = (const char*)g.Bt + (size_t)cur.pn * tstep;
    PG8_STAGE(PG8_SB(0, 0), cB, voffB); PG8_STAGE(PG8_SA(0, 0), cA, voffA); PG8_STAGE(PG8_SB(0, 1), cB + hstep, voffB); PG8_STAGE(PG8_SA(0, 1), cA + hstep, voffA);
    if (wr == 1) PG8_BAR;
    PG8_WAIT_V(4); PG8_BAR;
    PG8_STAGE(PG8_SB(1, 0), cB + kstep, voffB); PG8_STAGE(PG8_SA(1, 0), cA + kstep, voffA); PG8_STAGE(PG8_SB(1, 1), cB + hstep + kstep, voffB);
    PG8_WAIT_V(6); PG8_BAR;
    for (;;) {
        const bool has_next = S.next(ui + 1, nxt);
        const char* nA = has_next ? (const char*)g.A + (size_t)nxt.pm * tstep : cA; const char* nB = has_next ? (const char*)g.Bt + (size_t)nxt.pn * tstep : cB;
        for (int t = 0; t < nt; t += 2) {
            const bool last = (t == nt - 2);
            const char* a1 = cA + (size_t)(t + 1) * kstep;
            const char* a2 = last ? nA : cA + (size_t)(t + 2) * kstep; const char* b2 = last ? nB : cB + (size_t)(t + 2) * kstep;
            const char* a3 = a2 + kstep; const char* b3 = b2 + kstep;
            PG8_LDB(B0, 0, 0); PG8_SCHED; PG8_LDA(At, 0, 0); PG8_STAGE(PG8_SA(1, 1), a1 + hstep, voffA);
            PG8_WAIT_L(8); PG8_BAR; PG8_WAIT_L(0); PG8_MMA(0, 0, At, B0); PG8_BAR; PG8_SCHED;
            PG8_LDB(B1, 0, 1); PG8_STAGE(PG8_SB(0, 0), b2, voffB);
            PG8_BAR; PG8_WAIT_L(0); PG8_MMA(0, 1, At, B1); PG8_BAR;
            PG8_LDA(At, 0, 1); PG8_STAGE(PG8_SA(0, 0), a2, voffA);
            PG8_BAR; PG8_WAIT_L(0); PG8_MMA(1, 0, At, B0); PG8_BAR; PG8_SCHED;
            PG8_STAGE(PG8_SB(0, 1), b2 + hstep, voffB);
            PG8_WAIT_V(6); PG8_BAR; PG8_MMA(1, 1, At, B1); PG8_BAR;
            PG8_LDB(B0, 1, 0); PG8_SCHED; PG8_LDA(At, 1, 0); PG8_STAGE(PG8_SA(0, 1), a2 + hstep, voffA);
            PG8_WAIT_L(8); PG8_BAR; PG8_WAIT_L(0); PG8_MMA(0, 0, At, B0); PG8_BAR; PG8_SCHED;
            PG8_LDB(B1, 1, 1); PG8_STAGE(PG8_SB(1, 0), b3, voffB);
            PG8_BAR; PG8_WAIT_L(0); PG8_MMA(0, 1, At, B1); PG8_BAR;
            PG8_LDA(At, 1, 1); PG8_STAGE(PG8_SA(1, 0), a3, voffA);
            PG8_BAR; PG8_WAIT_L(0); PG8_MMA(1, 0, At, B0); PG8_BAR; PG8_SCHED;
            PG8_STAGE(PG8_SB(1, 1), b3 + hstep, voffB);
            PG8_WAIT_V(6); PG8_BAR; PG8_MMA(1, 1, At, B1); PG8_BAR;
            if constexpr (Epi::KHOOK) E.khook(acc, cur, t, wr, wc, fr, fq);
        }
        E(acc, cur, wr, wc, fr, fq);
        if (!has_next) break;
#pragma unroll
        for (int a = 0; a < 2; ++a)
#pragma unroll
            for (int b = 0; b < 2; ++b)
#pragma unroll
                for (int m = 0; m < 4; ++m)
#pragma unroll
                    for (int n = 0; n < 2; ++n) acc[a][b][m][n] = (f32x4){0.f, 0.f, 0.f, 0.f};
        cur = nxt; cA = nA; cB = nB; ++ui;
    }
    PG8_WAIT_V(0);
    if (wr == 0) PG8_BAR;
    PG8_BAR;
#undef PG8_SA
#undef PG8_SB
#undef PG8_STAGE
#undef PG8_LDA
#undef PG8_LDB
#undef PG8_MMA
#undef PG8_WAIT_V
#undef PG8_WAIT_L
#undef PG8_BAR
#undef PG8_SCHED
}
}
using pg8::Unit;
typedef f32x4 Acc[2][2][4][2];
#define EPI_UNROLL _Pragma("unroll")
DI void acc8(const Acc& acc, int ai, int bj, int m, float* v) {
    v[0] = acc[ai][bj][m][0][0]; v[1] = acc[ai][bj][m][0][1]; v[2] = acc[ai][bj][m][0][2]; v[3] = acc[ai][bj][m][0][3];
    v[4] = acc[ai][bj][m][1][0]; v[5] = acc[ai][bj][m][1][1]; v[6] = acc[ai][bj][m][1][2]; v[7] = acc[ai][bj][m][1][3];
}

struct EpiIn1 {
    static constexpr bool PERM = true, KHOOK = false;
    unsigned char* ws; const float* rope;
    DI void operator()(const Acc& acc, const Unit& u, int wr, int wc, int fr, int fq) const {
        const int pn = u.pn, row0 = u.pm * 256 + wr * 64 + fr, cl = wc * 32 + 8 * fq;
        if (pn < 8) {
            bf16_t* dst = (bf16_t*)(ws + (pn < 4 ? OFF_Q : OFF_K)); const float sc = pn < 4 ? 1.f : 0.0625f; const int cb = (pn & 3) * 256;
            EPI_UNROLL for (int ai = 0; ai < 2; ++ai) EPI_UNROLL for (int m = 0; m < 4; ++m) {
                const int row = row0 + ai * 128 + m * 16, pidx = row < NP ? (row & 2047) : 2048;
                const f32x4* rp = (const f32x4*)(rope + ((size_t)pidx * 128 + cl) * 2);
                float x1[8], x2[8], o1[8], o2[8]; acc8(acc, ai, 0, m, x1); acc8(acc, ai, 1, m, x2);
                EPI_UNROLL for (int q = 0; q < 4; ++q) { const f32x4 cs = rp[q];
                    o1[2 * q] = (x1[2 * q] * cs[0] - x2[2 * q] * cs[1]) * sc; o2[2 * q] = (x1[2 * q] * cs[1] + x2[2 * q] * cs[0]) * sc;
                    o1[2 * q + 1] = (x1[2 * q + 1] * cs[2] - x2[2 * q + 1] * cs[3]) * sc; o2[2 * q + 1] = (x1[2 * q + 1] * cs[3] + x2[2 * q + 1] * cs[2]) * sc; }
                bf16_t* rowp = dst + (size_t)row * 1024 + cb + cl;
                *(u32x4*)rowp = pack8(o1); *(u32x4*)(rowp + 128) = pack8(o2); __builtin_amdgcn_sched_barrier(0);
            }
        } else {
            size_t doff; int ld, cb, mode;
            if (pn < 16) { doff = OFF_SG; ld = 2048; cb = (pn - 8) * 256; mode = 0; }
            else if (pn < 20) { doff = OFF_GU; ld = 1024; cb = (pn - 16) * 256; mode = 1; }
            else if (pn < 24) { doff = OFF_AR; ld = 1024; cb = (pn - 20) * 256; mode = 2; }
            else { doff = OFF_AG; ld = 1024; cb = (pn - 24) * 256; mode = 2; }
            bf16_t* dst = (bf16_t*)(ws + doff);
            EPI_UNROLL for (int ai = 0; ai < 2; ++ai) EPI_UNROLL for (int m = 0; m < 4; ++m) {
                const int row = row0 + ai * 128 + m * 16;
                EPI_UNROLL for (int bj = 0; bj < 2; ++bj) { float v[8]; acc8(acc, ai, bj, m, v);
                    if (mode == 0) { EPI_UNROLL for (int e = 0; e < 8; ++e) v[e] = fsilu(v[e]); }
                    else if (mode == 1) { EPI_UNROLL for (int e = 0; e < 8; ++e) v[e] = fgelu(v[e]); }
                    else { EPI_UNROLL for (int e = 0; e < 8; ++e) v[e] = fsigmoid(v[e]); }
                    *(u32x4*)(dst + (size_t)row * ld + cb + bj * 128 + cl) = pack8(v); }
            }
        }
    }
};
struct EpiIn2 {
    static constexpr bool PERM = true, KHOOK = false;
    bf16_t *KT, *VT, *GVT; const float* rope; float *lnsum, *lnsq;
    DI void operator()(const Acc& acc, const Unit& u, int wr, int wc, int fr, int fq) const {
        const int pm = u.pm, tl = wc * 32 + 8 * fq;
        if (pm < 4) {
            EPI_UNROLL for (int m = 0; m < 4; ++m) { const int j = wr * 64 + m * 16 + fr;
                EPI_UNROLL for (int bj = 0; bj < 2; ++bj) { const int tok = u.pn * 256 + bj * 128 + tl;
                    float x1[8], x2[8], o1[8], o2[8]; acc8(acc, 0, bj, m, x1); acc8(acc, 1, bj, m, x2);
                    const int pbase = tok < NP ? (tok & 2047) : 2048, pinc = tok < NP ? 1 : 0;
                    EPI_UNROLL for (int e = 0; e < 8; ++e) { const f32x2 cs = *(const f32x2*)(rope + ((size_t)(pbase + pinc * e) * 128 + j) * 2);
                        o1[e] = (x1[e] * cs[0] - x2[e] * cs[1]) * 0.0625f; o2[e] = (x1[e] * cs[1] + x2[e] * cs[0]) * 0.0625f; }
                    *(u32x4*)(KT + (size_t)(pm * 256 + j) * MP + tok) = pack8(o1);
                    *(u32x4*)(KT + (size_t)(pm * 256 + 128 + j) * MP + tok) = pack8(o2); __builtin_amdgcn_sched_barrier(0); } }
        } else if (pm < 12) {
            EPI_UNROLL for (int ai = 0; ai < 2; ++ai) EPI_UNROLL for (int m = 0; m < 4; ++m) { const int r = (pm - 4) * 256 + ai * 128 + wr * 64 + m * 16 + fr;
                EPI_UNROLL for (int bj = 0; bj < 2; ++bj) { float v[8]; acc8(acc, ai, bj, m, v);
                    *(u32x4*)(VT + (size_t)r * MP + u.pn * 256 + bj * 128 + tl) = pack8(v); } }
        } else {
            EPI_UNROLL for (int bj = 0; bj < 2; ++bj) {
                float s1[8], s2[8];
                EPI_UNROLL for (int e = 0; e < 8; ++e) { s1[e] = 0.f; s2[e] = 0.f; }
                EPI_UNROLL for (int ai = 0; ai < 2; ++ai) EPI_UNROLL for (int m = 0; m < 4; ++m) { const int r = (pm - 12) * 256 + ai * 128 + wr * 64 + m * 16 + fr;
                    float v[8]; acc8(acc, ai, bj, m, v);
                    EPI_UNROLL for (int e = 0; e < 8; ++e) { v[e] = fgelu(v[e]); s1[e] += v[e]; s2[e] += v[e] * v[e]; }
                    *(u32x4*)(GVT + (size_t)r * MP + u.pn * 256 + bj * 128 + tl) = pack8(v); __builtin_amdgcn_sched_barrier(0); }
                EPI_UNROLL for (int e = 0; e < 8; ++e) {
                    float a = s1[e], b = s2[e];
                    EPI_UNROLL for (int msk = 1; msk < 16; msk <<= 1) { a += __shfl_xor(a, msk); b += __shfl_xor(b, msk); }
                    if (fr == 0) { const int tok = u.pn * 256 + bj * 128 + tl + e; unsafeAtomicAdd(lnsum + tok, a); unsafeAtomicAdd(lnsq + tok, b); } }
                __builtin_amdgcn_sched_barrier(0);
            }
        }
    }
};
struct EpiRet {
    static constexpr bool PERM = true, KHOOK = true;
    const float* sso; const bf16_t* AR; float* T1;
    DI void khook(Acc& acc, const Unit& u, int t, int wr, int wc, int fr, int fq) const {
        const int kt = t + 2; if ((kt & 7) != 0 || kt >= 32) return;
        const int h = (kt >> 3) - 1;
        EPI_UNROLL for (int ai = 0; ai < 2; ++ai) EPI_UNROLL for (int m = 0; m < 4; ++m) { const int row = u.pm * 256 + ai * 128 + wr * 64 + m * 16 + fr;
            const float a = sso[row * 4 + h] * (1.f / 512.f) + EPSF, b = sso[row * 4 + h + 1] * (1.f / 512.f) + EPSF;
            const float f = sqrtf(b / a);
            EPI_UNROLL for (int bj = 0; bj < 2; ++bj) EPI_UNROLL for (int n = 0; n < 2; ++n) acc[ai][bj][m][n] *= f; __builtin_amdgcn_sched_barrier(0); }
    }
    DI void operator()(const Acc& acc, const Unit& u, int wr, int wc, int fr, int fq) const {
        EPI_UNROLL for (int ai = 0; ai < 2; ++ai) EPI_UNROLL for (int m = 0; m < 4; ++m) { const int row = u.pm * 256 + ai * 128 + wr * 64 + m * 16 + fr;
            const float r3 = rsqrtf(sso[row * 4 + 3] * (1.f / 512.f) + EPSF);
            EPI_UNROLL for (int bj = 0; bj < 2; ++bj) { const int col = u.pn * 256 + bj * 128 + wc * 32 + 8 * fq;
                float v[8], g[8]; acc8(acc, ai, bj, m, v); unpack8(*(const u32x4*)(AR + (size_t)row * 1024 + col), g);
                f32x4 o0, o1; EPI_UNROLL for (int e = 0; e < 4; ++e) { o0[e] = v[e] * r3 * g[e]; o1[e] = v[4 + e] * r3 * g[4 + e]; }
                *(f32x4*)(T1 + (size_t)row * 1024 + col) = o0; *(f32x4*)(T1 + (size_t)row * 1024 + col + 4) = o1; } __builtin_amdgcn_sched_barrier(0); }
    }
};
struct EpiGm {
    static constexpr bool PERM = true, KHOOK = false;
    const float* T1; const bf16_t* AG; bf16_t* MM;
    DI void operator()(const Acc& acc, const Unit& u, int wr, int wc, int fr, int fq) const {
        EPI_UNROLL for (int ai = 0; ai < 2; ++ai) EPI_UNROLL for (int m = 0; m < 4; ++m) { const int row = u.pm * 256 + ai * 128 + wr * 64 + m * 16 + fr;
            EPI_UNROLL for (int bj = 0; bj < 2; ++bj) { const int col = u.pn * 256 + bj * 128 + wc * 32 + 8 * fq;
                float v[8], g[8]; acc8(acc, ai, bj, m, v); unpack8(*(const u32x4*)(AG + (size_t)row * 1024 + col), g);
                const f32x4 t0 = *(const f32x4*)(T1 + (size_t)row * 1024 + col), t1 = *(const f32x4*)(T1 + (size_t)row * 1024 + col + 4);
                EPI_UNROLL for (int e = 0; e < 4; ++e) { v[e] = t0[e] + g[e] * v[e]; v[4 + e] = t1[e] + g[4 + e] * v[4 + e]; }
                *(u32x4*)(MM + (size_t)row * 1024 + col) = pack8(v); } __builtin_amdgcn_sched_barrier(0); }
    }
};
struct EpiO {
    static constexpr bool PERM = true, KHOOK = false;
    const float *xp, *xs; float* H; bf16_t* HB; float* ssh;
    DI void operator()(const Acc& acc, const Unit& u, int wr, int wc, int fr, int fq) const {
        EPI_UNROLL for (int ai = 0; ai < 2; ++ai) EPI_UNROLL for (int m = 0; m < 4; ++m) { const int row = u.pm * 256 + ai * 128 + wr * 64 + m * 16 + fr;
            const float* xr = row < NP ? xp + (size_t)row * 1024 : xs + (size_t)(row < MR ? row - NP : 0) * 1024;
            const bool real = row < MR; float ss = 0.f;
            EPI_UNROLL for (int bj = 0; bj < 2; ++bj) { const int col = u.pn * 256 + bj * 128 + wc * 32 + 8 * fq;
                float v[8]; acc8(acc, ai, bj, m, v);
                f32x4 x0 = *(const f32x4*)(xr + col), x1 = *(const f32x4*)(xr + col + 4);
                if (!real) { x0 = (f32x4){0.f, 0.f, 0.f, 0.f}; x1 = x0; }
                EPI_UNROLL for (int e = 0; e < 4; ++e) { v[e] += x0[e]; v[4 + e] += x1[e]; }
                EPI_UNROLL for (int e = 0; e < 8; ++e) ss += v[e] * v[e];
                *(f32x4*)(H + (size_t)row * 1024 + col) = (f32x4){v[0], v[1], v[2], v[3]}; *(f32x4*)(H + (size_t)row * 1024 + col + 4) = (f32x4){v[4], v[5], v[6], v[7]};
                *(u32x4*)(HB + (size_t)row * 1024 + col) = pack8(v); }
            ss += __shfl_xor(ss, 16); ss += __shfl_xor(ss, 32);
            if (fq == 0) unsafeAtomicAdd(ssh + row, ss); __builtin_amdgcn_sched_barrier(0); }
    }
};
struct EpiF1 {
    static constexpr bool PERM = true, KHOOK = false;
    const float* ssh; bf16_t* ACT;
    DI void operator()(const Acc& acc, const Unit& u, int wr, int wc, int fr, int fq) const {
        EPI_UNROLL for (int ai = 0; ai < 2; ++ai) EPI_UNROLL for (int m = 0; m < 4; ++m) { const int row = u.pm * 256 + ai * 128 + wr * 64 + m * 16 + fr;
            const float rs = rsqrtf(ssh[row] * (1.f / 1024.f) + EPSF);
            float g[8], p[8]; acc8(acc, ai, 0, m, g); acc8(acc, ai, 1, m, p);
            EPI_UNROLL for (int e = 0; e < 8; ++e) g[e] = fsilu(g[e] * rs) * (p[e] * rs);
            *(u32x4*)(ACT + (size_t)row * 2816 + u.pn * 128 + wc * 32 + 8 * fq) = pack8(g); }
    }
};
struct EpiF2 {
    static constexpr bool PERM = true, KHOOK = false;
    const float* H; float* Y; float* ssh2;
    DI void operator()(const Acc& acc, const Unit& u, int wr, int wc, int fr, int fq) const {
        EPI_UNROLL for (int ai = 0; ai < 2; ++ai) EPI_UNROLL for (int m = 0; m < 4; ++m) { const int row = u.pm * 256 + ai * 128 + wr * 64 + m * 16 + fr;
            float ss = 0.f;
            if (row < MR) {
                EPI_UNROLL for (int bj = 0; bj < 2; ++bj) { const int col = u.pn * 256 + bj * 128 + wc * 32 + 8 * fq;
                    float v[8]; acc8(acc, ai, bj, m, v);
                    const f32x4 h0 = *(const f32x4*)(H + (size_t)row * 1024 + col), h1 = *(const f32x4*)(H + (size_t)row * 1024 + col + 4);
                    EPI_UNROLL for (int e = 0; e < 4; ++e) { v[e] += h0[e]; v[4 + e] += h1[e]; }
                    EPI_UNROLL for (int e = 0; e < 8; ++e) ss += v[e] * v[e];
                    *(f32x4*)(Y + (size_t)row * 1024 + col) = (f32x4){v[0], v[1], v[2], v[3]}; *(f32x4*)(Y + (size_t)row * 1024 + col + 4) = (f32x4){v[4], v[5], v[6], v[7]}; }
            }
            ss += __shfl_xor(ss, 16); ss += __shfl_xor(ss, 32);
            if (fq == 0 && row < MR) unsafeAtomicAdd(ssh2 + row, ss); __builtin_amdgcn_sched_barrier(0); }
    }
};

DI double dpow_int(double base, int n) { double r = 1.0; for (int b = 0; b < 8; ++b) { if ((n >> b) & 1) r *= base; base *= base; } return r; }

DI void wtile(const Params& P, ldsp lds, int job) {
    const int tid = opaque_tid();
    const float* src; int N, kt, ntile; const float* ksc = nullptr;
    bf16_t* d0 = nullptr; bf16_t* d1 = nullptr; int ldk, hi0 = 128; long r0 = 0, r1 = 0;
    unsigned char* ws = P.ws;
    if (job < 640) { src = P.in[4]; N = 10240; kt = job / 40; ntile = job % 40; ldk = 1024;
        const int n0 = ntile * 256, sec = n0 >> 10;
        bf16_t* W1 = (bf16_t*)(ws + OFF_WT1); bf16_t* W2 = (bf16_t*)(ws + OFF_WT2);
        if (sec == 0) { d0 = W1; r0 = n0; }
        else if (sec == 1) { d0 = W1; r0 = n0; d1 = W2; r1 = n0 - 1024; }
        else if (sec < 4) { d0 = W2; r0 = 1024 + (n0 - 2048); }
        else if (sec < 6) { d0 = W1; r0 = 2048 + (n0 - 4096); }
        else if (sec == 6) { d0 = W1; r0 = 4096 + (n0 - 6144); }
        else if (sec == 7) { d0 = W2; r0 = 3072 + (n0 - 7168); }
        else if (sec == 8) { d0 = W1; r0 = 5120 + (n0 - 8192); }
        else { d0 = W1; r0 = 6144 + (n0 - 9216); }
    } else if (job < 768) { const int j = job - 640; src = P.in[5]; N = 1024; kt = j / 4; ntile = j % 4; ldk = 2048; d0 = (bf16_t*)(ws + OFF_WRET); r0 = ntile * 256; }
    else if (job < 832) { const int j = job - 768; src = P.in[10]; N = 1024; kt = j / 4; ntile = j % 4; ldk = 1024; d0 = (bf16_t*)(ws + OFF_WGM); r0 = ntile * 256; }
    else if (job < 896) { const int j = job - 832; src = P.in[11]; N = 1024; kt = j / 4; ntile = j % 4; ldk = 1024; d0 = (bf16_t*)(ws + OFF_WO); r0 = ntile * 256; }
    else if (job < 1248) { const int j = job - 896; src = P.in[13]; N = 5632; kt = j / 22; ntile = j % 22; ldk = 1024; d0 = (bf16_t*)(ws + OFF_WF1); ksc = P.in[12];
        const int n0 = ntile * 256; hi0 = 256; r0 = n0 < 2816 ? 2 * n0 : 2 * (n0 - 2816) + 128; }
    else { const int j = job - 1248; src = P.in[14]; N = 1024; kt = j / 4; ntile = j % 4; ldk = 2816; d0 = (bf16_t*)(ws + OFF_WF2); r0 = ntile * 256; }
    const int k0 = kt * 64, n0 = ntile * 256;
    LAS float* tile = (LAS float*)lds;
    __syncthreads();
    {
        const int n4 = (tid & 63) * 4, kb = tid >> 6;
        f32x4 v[8];
#pragma unroll
        for (int i = 0; i < 8; ++i) v[i] = *(const f32x4*)(src + (size_t)(k0 + kb + 8 * i) * N + n0 + n4);
#pragma unroll
        for (int i = 0; i < 8; ++i) { const int k = kb + 8 * i; const float s = ksc ? ksc[k0 + k] : 1.f;
            tile[k * 257 + n4] = v[i][0] * s; tile[k * 257 + n4 + 1] = v[i][1] * s; tile[k * 257 + n4 + 2] = v[i][2] * s; tile[k * 257 + n4 + 3] = v[i][3] * s; }
    }
    __syncthreads();
#pragma unroll
    for (int i = 0; i < 4; ++i) { const int item = tid + 512 * i, n = item >> 3, seg = item & 7;
        float v[8];
#pragma unroll
        for (int e = 0; e < 8; ++e) v[e] = tile[(seg * 8 + e) * 257 + n];
        const u32x4 p = pack8(v);
        const long rl = (n & 127) + (long)(n >> 7) * hi0;
        *(u32x4*)(d0 + (size_t)(r0 + rl) * ldk + k0 + seg * 8) = p;
        if (d1) *(u32x4*)(d1 + (size_t)(r1 + rl) * ldk + k0 + seg * 8) = p; }
}

DI void phase0(const Params& P, ldsp lds) {
    const int tid = opaque_tid(), G = gridDim.x;
    const size_t gtid = (size_t)blockIdx.x * 512 + tid, gsz = (size_t)G * 512;
    float* st = (float*)(P.ws + OFF_ST);
    for (size_t i = gtid; i < (size_t)MP * 8; i += gsz) st[i] = 0.f;
    float* rope = (float*)(P.ws + OFF_ROPE);
    for (size_t i = gtid; i < (size_t)2049 * 128; i += gsz) { const int pidx = (int)(i >> 7), j = (int)(i & 127);
        const double inv = dpow_int(0.9305720409296989, j);
        const double pos = pidx < 2048 ? (double)pidx : 16384.0;
        double rev = pos * inv * 0.15915494309189535; rev -= floor(rev);
        const float fr = (float)rev;
        rope[2 * i] = __builtin_amdgcn_cosf(fr); rope[2 * i + 1] = __builtin_amdgcn_sinf(fr); }
    { const int wave = tid >> 6, lane = tid & 63; bf16_t* XN = (bf16_t*)(P.ws + OFF_XN); const float* g = P.in[3];
      for (int row = blockIdx.x * 8 + wave; row < MP; row += G * 8) {
          u32x4 o0 = (u32x4){0u, 0u, 0u, 0u}, o1 = o0;
          if (row < MR) { const float* xr = row < NP ? P.in[0] + (size_t)row * 1024 : P.in[1] + (size_t)(row - NP) * 1024;
              f32x4 v[4]; float ss = 0.f;
#pragma unroll
              for (int i = 0; i < 4; ++i) { v[i] = *(const f32x4*)(xr + lane * 16 + i * 4); ss += v[i][0] * v[i][0] + v[i][1] * v[i][1] + v[i][2] * v[i][2] + v[i][3] * v[i][3]; }
#pragma unroll
              for (int msk = 1; msk < 64; msk <<= 1) ss += __shfl_xor(ss, msk);
              const float rs = rsqrtf(ss * (1.f / 1024.f) + EPSF);
              float o[16];
#pragma unroll
              for (int i = 0; i < 4; ++i) { const f32x4 gg = *(const f32x4*)(g + lane * 16 + i * 4);
#pragma unroll
                  for (int e = 0; e < 4; ++e) o[i * 4 + e] = v[i][e] * rs * gg[e]; }
              o0 = pack8(o); o1 = pack8(o + 8); }
          *(u32x4*)(XN + (size_t)row * 1024 + lane * 16) = o0; *(u32x4*)(XN + (size_t)row * 1024 + lane * 16 + 8) = o1; } }
    for (int job = blockIdx.x; job < 1424; job += G) wtile(P, lds, job);
}

DI void retention_prompt(const Params& P, ldsp lds, int item) {
    const int tid = opaque_tid(), wid = tid >> 6, lane = tid & 63, r = lane & 31, hh = lane >> 5;
    const int xcd = item & 7, idx = item >> 3, pair = xcd * 4 + (idx >> 3), dvs = idx & 7, b = pair >> 2, h = pair & 3;
    constexpr int QH = 0, KH = 34816, VTS = 69632, VTD = 87040, STS = 104448, GAM = 138240;
    const bf16_t* Q = (const bf16_t*)(P.ws + OFF_Q); const bf16_t* Kk = (const bf16_t*)(P.ws + OFF_K);
    const bf16_t* KT = (const bf16_t*)(P.ws + OFF_KT); const bf16_t* VT = (const bf16_t*)(P.ws + OFF_VT);
    const bf16_t* SG = (const bf16_t*)(P.ws + OFF_SG); bf16_t* RO = (bf16_t*)(P.ws + OFF_RO);
    float* sso = (float*)(P.ws + OFF_ST);
    LAS float* gam = (LAS float*)(lds + GAM);
    __syncthreads();
    if (tid <= 128) gam[tid] = (float)dpow_int(1.0 - __builtin_ldexp(1.0, -5 - h), tid);
    const int tt = wid >> 1, ss0 = (wid & 1) * 2, dd = wid & 1, dkt = wid >> 1;
    f32x16 Sacc[2];
#pragma unroll
    for (int i = 0; i < 16; ++i) { Sacc[0][i] = 0.f; Sacc[1][i] = 0.f; }
    for (int c = 0; c < 16; ++c) {
        int tok0 = b * 2048 + c * 128; asm volatile("" : "+s"(tok0));
        __syncthreads();
#pragma unroll
        for (int i = 0; i < 2; ++i) { const int it = tid + 512 * i, row = it >> 4, seg = it & 15;
            const u32x4 v = *(const u32x4*)(VT + (size_t)(h * 512 + dvs * 64 + row) * MP + tok0 + seg * 8);
            *(LAS u32x4*)(lds + VTS + row * 272 + seg * 16) = v;
            float f[8]; unpack8(v, f);
#pragma unroll
            for (int e = 0; e < 8; ++e) f[e] *= gam[127 - (seg * 8 + e)];
            *(LAS u32x4*)(lds + VTD + row * 272 + seg * 16) = pack8(f); }
        f32x16 sacc[2], oacc;
#pragma unroll
        for (int i = 0; i < 16; ++i) { sacc[0][i] = 0.f; sacc[1][i] = 0.f; oacc[i] = 0.f; }
        for (int half = 0; half < 2; ++half) {
            if (half) __syncthreads();
#pragma unroll
            for (int i = 0; i < 4; ++i) { const int it = tid + 512 * i, row = it >> 4, seg = it & 15;
                const size_t go = (size_t)(tok0 + row) * 1024 + h * 256 + half * 128 + seg * 8;
                *(LAS u32x4*)(lds + QH + row * 272 + seg * 16) = *(const u32x4*)(Q + go);
                *(LAS u32x4*)(lds + KH + row * 272 + seg * 16) = *(const u32x4*)(Kk + go); }
            __syncthreads();
#pragma unroll 2
            for (int ks = 0; ks < 8; ++ks) {
                const int ko = (ks * 16 + hh * 8) * 2;
                const bf16x8 bq = *(const LAS bf16x8*)(lds + QH + (tt * 32 + r) * 272 + ko);
#pragma unroll
                for (int u = 0; u < 2; ++u) { const bf16x8 ak = *(const LAS bf16x8*)(lds + KH + ((ss0 + u) * 32 + r) * 272 + ko); sacc[u] = MFMA32(ak, bq, sacc[u]); }
                if (c > 0) { const bf16x8 bs = *(const LAS bf16x8*)(lds + STS + (dd * 32 + r) * 528 + (half * 128 + ks * 16 + hh * 8) * 2); oacc = MFMA32(bq, bs, oacc); }
            }
        }
        __syncthreads();
#pragma unroll
        for (int i = 0; i < 4; ++i) { const int it = tid + 512 * i, row = it >> 4, seg = it & 15;
            *(LAS u32x4*)(lds + KH + row * 272 + seg * 16) = *(const u32x4*)(KT + (size_t)(h * 256 + row) * MP + tok0 + seg * 8); }
#pragma unroll
        for (int u = 0; u < 2; ++u) {
#pragma unroll
            for (int g = 0; g < 4; ++g) { float pv[4]; const int t = tt * 32 + r;
#pragma unroll
                for (int e = 0; e < 4; ++e) { const int s = (ss0 + u) * 32 + 8 * g + 4 * hh + e; const int d = t - s; pv[e] = d >= 0 ? sacc[u][4 * g + e] * gam[d >= 0 ? d : 0] : 0.f; }
                u32x2 pk; pk[0] = cvt_pk_bf16(pv[0], pv[1]); pk[1] = cvt_pk_bf16(pv[2], pv[3]);
                *(LAS u32x2*)(lds + QH + t * 272 + ((ss0 + u) * 32 + 8 * g + 4 * hh) * 2) = pk; } }
#pragma unroll
        for (int i = 0; i < 16; ++i) { const int tl = tt * 32 + (i & 3) + 8 * (i >> 2) + 4 * hh; oacc[i] *= gam[tl + 1]; }
        __syncthreads();
        for (int ks = 0; ks < 2 * (tt + 1); ++ks) { const int ko = (ks * 16 + hh * 8) * 2;
            const bf16x8 ap = *(const LAS bf16x8*)(lds + QH + (tt * 32 + r) * 272 + ko);
            const bf16x8 bv = *(const LAS bf16x8*)(lds + VTS + (dd * 32 + r) * 272 + ko);
            oacc = MFMA32(ap, bv, oacc); }
        const float g128 = gam[128];
#pragma unroll
        for (int i = 0; i < 16; ++i) { Sacc[0][i] *= g128; Sacc[1][i] *= g128; }
#pragma unroll 2
        for (int ks = 0; ks < 8; ++ks) { const int ko = (ks * 16 + hh * 8) * 2;
            const bf16x8 ak = *(const LAS bf16x8*)(lds + KH + (dkt * 32 + r) * 272 + ko);
            const bf16x8 bv = *(const LAS bf16x8*)(lds + VTD + (dd * 32 + r) * 272 + ko);
            Sacc[0] = MFMA32(ak, bv, Sacc[0]); }
        { const int col = h * 512 + dvs * 64 + dd * 32 + r;
#pragma unroll
          for (int i = 0; i < 16; ++i) { const int tl = tt * 32 + (i & 3) + 8 * (i >> 2) + 4 * hh; const size_t tok = (size_t)tok0 + tl;
              const float o = oacc[i]; const float sg = bf2f(SG[tok * 2048 + col]);
              RO[tok * 2048 + col] = f2bf(sg * o);
              float q = o * o;
#pragma unroll
              for (int msk = 1; msk < 32; msk <<= 1) q += __shfl_xor(q, msk);
              if (r == 0) unsafeAtomicAdd(sso + tok * 4 + h, q); } }
        __syncthreads();
#pragma unroll
        for (int i = 0; i < 4; ++i) { const int it = tid + 512 * i, row = it >> 4, seg = it & 15;
            *(LAS u32x4*)(lds + QH + row * 272 + seg * 16) = *(const u32x4*)(KT + (size_t)(h * 256 + 128 + row) * MP + tok0 + seg * 8); }
        __syncthreads();
#pragma unroll 2
        for (int ks = 0; ks < 8; ++ks) { const int ko = (ks * 16 + hh * 8) * 2;
            const bf16x8 ak = *(const LAS bf16x8*)(lds + QH + (dkt * 32 + r) * 272 + ko);
            const bf16x8 bv = *(const LAS bf16x8*)(lds + VTD + (dd * 32 + r) * 272 + ko);
            Sacc[1] = MFMA32(ak, bv, Sacc[1]); }
#pragma unroll
        for (int hf = 0; hf < 2; ++hf)
#pragma unroll
            for (int g = 0; g < 4; ++g) { const int dk = hf * 128 + dkt * 32 + 8 * g + 4 * hh;
                u32x2 pk; pk[0] = cvt_pk_bf16(Sacc[hf][4 * g], Sacc[hf][4 * g + 1]); pk[1] = cvt_pk_bf16(Sacc[hf][4 * g + 2], Sacc[hf][4 * g + 3]);
                *(LAS u32x2*)(lds + STS + (dd * 32 + r) * 528 + dk * 2) = pk; }
    }
    float* sp = P.out + OUT_SP + (size_t)(b * 4 + h) * 256 * 512 + dvs * 64 + dd * 32 + r;
#pragma unroll
    for (int hf = 0; hf < 2; ++hf)
#pragma unroll
        for (int i = 0; i < 16; ++i) { const int dk = hf * 128 + dkt * 32 + (i & 3) + 8 * (i >> 2) + 4 * hh; sp[(size_t)dk * 512] = Sacc[hf][i]; }
}

DI void retention_sample(const Params& P, ldsp lds, int item) {
    const int tid = opaque_tid(), lane = tid & 63;
    const int bs = item >> 2, h = item & 3; const size_t tok = (size_t)NP + bs;
    const bf16_t* Q = (const bf16_t*)(P.ws + OFF_Q); const bf16_t* Kk = (const bf16_t*)(P.ws + OFF_K); const bf16_t* VT = (const bf16_t*)(P.ws + OFF_VT);
    const bf16_t* SG = (const bf16_t*)(P.ws + OFF_SG); bf16_t* RO = (bf16_t*)(P.ws + OFF_RO); float* sso = (float*)(P.ws + OFF_ST);
    LAS float* QF = (LAS float*)lds; LAS float* KF = QF + 256; LAS float* VF = QF + 512; LAS float* RED = QF + 1024;
    __syncthreads();
    if (tid < 256) { QF[tid] = bf2f(Q[tok * 1024 + h * 256 + tid]); KF[tid] = bf2f(Kk[tok * 1024 + h * 256 + tid]); }
    VF[tid] = bf2f(VT[(size_t)(h * 512 + tid) * MP + tok]);
    __syncthreads();
    float qk = 0.f;
#pragma unroll
    for (int i = 0; i < 4; ++i) qk += QF[lane + 64 * i] * KF[lane + 64 * i];
#pragma unroll
    for (int msk = 1; msk < 64; msk <<= 1) qk += __shfl_xor(qk, msk);
    const float gamma = 1.f - __builtin_ldexpf(1.f, -5 - h);
    const int dv4 = (tid & 127) * 4, kg = tid >> 7;
    const size_t sb = ((size_t)(bs * 4 + h) * 256 + kg * 64) * 512 + dv4;
    const f32x4* S0 = (const f32x4*)(P.in[2] + sb); f32x4* S1 = (f32x4*)(P.out + OUT_SS + sb);
    const f32x4 v4 = *(const LAS f32x4*)(VF + dv4);
    f32x4 a4 = (f32x4){0.f, 0.f, 0.f, 0.f};
    for (int i0 = 0; i0 < 64; i0 += 8) {
        f32x4 s[8];
#pragma unroll
        for (int i = 0; i < 8; ++i) s[i] = __builtin_nontemporal_load(S0 + (size_t)(i0 + i) * 128);
#pragma unroll
        for (int i = 0; i < 8; ++i) { const float q = QF[kg * 64 + i0 + i], k = KF[kg * 64 + i0 + i];
            a4 += q * s[i];
            __builtin_nontemporal_store(gamma * s[i] + k * v4, S1 + (size_t)(i0 + i) * 128); }
    }
    *(LAS f32x4*)(RED + kg * 512 + dv4) = a4;
    __syncthreads();
    const float qs = RED[tid] + RED[512 + tid] + RED[1024 + tid] + RED[1536 + tid];
    const float o = qk * VF[tid] + gamma * qs;
    float q2 = o * o;
#pragma unroll
    for (int msk = 1; msk < 64; msk <<= 1) q2 += __shfl_xor(q2, msk);
    if (lane == 0) unsafeAtomicAdd(sso + tok * 4 + h, q2);
    RO[tok * 2048 + h * 512 + tid] = f2bf(bf2f(SG[tok * 2048 + h * 512 + tid]) * o);
}

DI void gmlp_prompt(const Params& P, ldsp lds, int item) {
    const int tid = opaque_tid(), wid = tid >> 6, lane = tid & 63, r = lane & 31, hh = lane >> 5;
    const int b = item >> 6, c = (item >> 2) & 15, g = item & 3, tok0 = b * 2048 + c * 128;
    constexpr int WS_ = 0, GV = 34816, MU = 104448, RS = 104960;
    const bf16_t* GVT = (const bf16_t*)(P.ws + OFF_GVT); const bf16_t* GU = (const bf16_t*)(P.ws + OFF_GU); bf16_t* GI = (bf16_t*)(P.ws + OFF_GI);
    const float* st = (const float*)(P.ws + OFF_ST); const float* lnsum = st + (size_t)MP * 4; const float* lnsq = st + (size_t)MP * 5;
    LAS float* mu = (LAS float*)(lds + MU); LAS float* rs = (LAS float*)(lds + RS);
    __syncthreads();
    if (tid < 128) { const float s1 = lnsum[tok0 + tid], s2 = lnsq[tok0 + tid]; const float m = s1 * (1.f / 1024.f); const float var = fmaxf(s2 * (1.f / 1024.f) - m * m, 0.f);
        mu[tid] = m; rs[tid] = rsqrtf(var + EPSF); }
    { const float* W = P.in[8] + (size_t)g * 16384;
#pragma unroll
      for (int i = 0; i < 4; ++i) { const int it = tid + 512 * i, t = it >> 4, seg = it & 15;
          const f32x4 w0 = *(const f32x4*)(W + t * 128 + seg * 8), w1 = *(const f32x4*)(W + t * 128 + seg * 8 + 4);
          float v[8] = {w0[0], w0[1], w0[2], w0[3], w1[0], w1[1], w1[2], w1[3]};
#pragma unroll
          for (int e = 0; e < 8; ++e) v[e] = (seg * 8 + e <= t) ? v[e] : 0.f;
          *(LAS u32x4*)(lds + WS_ + t * 272 + seg * 16) = pack8(v); } }
    __syncthreads();
    { const float* lg = P.in[6] + g * 256; const float* lb = P.in[7] + g * 256;
#pragma unroll
      for (int i = 0; i < 8; ++i) { const int it = tid + 512 * i, row = it >> 4, seg = it & 15;
          const u32x4 x = *(const u32x4*)(GVT + (size_t)(g * 256 + row) * MP + tok0 + seg * 8);
          float v[8]; unpack8(x, v); const float a = lg[row], bb = lb[row];
#pragma unroll
          for (int e = 0; e < 8; ++e) v[e] = (v[e] - mu[seg * 8 + e]) * rs[seg * 8 + e] * a + bb;
          *(LAS u32x4*)(lds + GV + row * 272 + seg * 16) = pack8(v); } }
    __syncthreads();
    const int tt = wid & 3, cb = (wid >> 2) * 4;
    f32x16 acc[4];
#pragma unroll
    for (int u = 0; u < 4; ++u)
#pragma unroll
        for (int i = 0; i < 16; ++i) acc[u][i] = 0.f;
    for (int ks = 0; ks < 2 * (tt + 1); ++ks) { const int ko = (ks * 16 + hh * 8) * 2;
        const bf16x8 a = *(const LAS bf16x8*)(lds + WS_ + (tt * 32 + r) * 272 + ko);
#pragma unroll
        for (int u = 0; u < 4; ++u) { const bf16x8 bv = *(const LAS bf16x8*)(lds + GV + ((cb + u) * 32 + r) * 272 + ko); acc[u] = MFMA32(a, bv, acc[u]); } }
    const float* bias = P.in[9] + g * 128;
#pragma unroll
    for (int i = 0; i < 16; ++i) { const int tl = tt * 32 + (i & 3) + 8 * (i >> 2) + 4 * hh; const size_t tok = (size_t)tok0 + tl; const float bi = bias[tl];
#pragma unroll
        for (int u = 0; u < 4; ++u) { const int ch = g * 256 + (cb + u) * 32 + r;
            GI[tok * 1024 + ch] = f2bf(bf2f(GU[tok * 1024 + ch]) * (acc[u][i] + bi)); } }
}
DI void gmlp_sample(const Params& P) {
    const bf16_t* GVT = (const bf16_t*)(P.ws + OFF_GVT); const bf16_t* GU = (const bf16_t*)(P.ws + OFF_GU); bf16_t* GI = (bf16_t*)(P.ws + OFF_GI);
    const float* st = (const float*)(P.ws + OFF_ST); const float* lnsum = st + (size_t)MP * 4; const float* lnsq = st + (size_t)MP * 5;
    for (size_t i = (size_t)blockIdx.x * 512 + threadIdx.x; i < (size_t)NSAMP * 1024; i += (size_t)gridDim.x * 512) {
        const int bs = (int)(i >> 10), ch = (int)(i & 1023), g = ch >> 8; const size_t tok = (size_t)NP + bs;
        const float m = lnsum[tok] * (1.f / 1024.f), var = fmaxf(lnsq[tok] * (1.f / 1024.f) - m * m, 0.f), rstd = rsqrtf(var + EPSF);
        const float x = bf2f(GVT[(size_t)ch * MP + tok]);
        const float gvn = (x - m) * rstd * P.in[6][ch] + P.in[7][ch];
        P.out[OUT_GV + i] = gvn;
        const float mixed = P.in[8][(size_t)g * 16384] * gvn + P.in[9][g * 128];
        GI[tok * 1024 + ch] = f2bf(bf2f(GU[tok * 1024 + ch]) * mixed);
    }
}

DI void final_norm(const Params& P) {
    const float* ss2 = (const float*)(P.ws + OFF_ST) + (size_t)MP * 7; const float* g = P.in[15];
    for (size_t i = (size_t)blockIdx.x * 512 + threadIdx.x; i < (size_t)MR * 256; i += (size_t)gridDim.x * 512) {
        const int row = (int)(i >> 8), c4 = (int)(i & 255) * 4;
        const float rs = rsqrtf(ss2[row] * (1.f / 1024.f) + EPSF);
        f32x4 v = *(f32x4*)(P.out + OUT_Y + (size_t)row * 1024 + c4); const f32x4 gg = *(const f32x4*)(g + c4);
        v[0] *= rs * gg[0]; v[1] *= rs * gg[1]; v[2] *= rs * gg[2]; v[3] *= rs * gg[3];
        *(f32x4*)(P.out + OUT_Y + (size_t)row * 1024 + c4) = v;
    }
}

__global__ void __launch_bounds__(512, 2) fwd_megakernel(Params P) {
    extern __shared__ __attribute__((aligned(16))) unsigned char shm[];
    ldsp lds = (ldsp)shm;
    cg::grid_group grid = cg::this_grid();
    const int G = gridDim.x, c = blockIdx.x;
    unsigned char* ws = P.ws;
#define RELAUNDER() asm volatile("" : "+s"(ws))
    float* st = (float*)(ws + OFF_ST);
    float* sso = st; float* lnsum = st + (size_t)MP * 4; float* lnsq = st + (size_t)MP * 5; float* ssh = st + (size_t)MP * 6; float* ssh2 = st + (size_t)MP * 7;
    const float* rope = (const float*)(ws + OFF_ROPE);

#ifndef PHMASK
#define PHMASK 0xfff
#endif
    if (PHMASK & 1) phase0(P, lds);
    grid.sync();
    if (PHMASK & 2) {
        pg8::Gemm g1{(const bf16_t*)(ws + OFF_XN), (const bf16_t*)(ws + OFF_WT1), MP, 7168, 1024};
        pg8::Order s1; s1.init(MP, 7168, G, c);
        EpiIn1 e1{ws, rope};
        pg8::gemm_phase(lds, g1, s1, e1);
        pg8::Gemm g2{(const bf16_t*)(ws + OFF_WT2), (const bf16_t*)(ws + OFF_XN), 4096, MP, 1024};
        pg8::Order s2; s2.init(4096, MP, G, (c + G - (s1.nwg % G)) % G);
        EpiIn2 e2{(bf16_t*)(ws + OFF_KT), (bf16_t*)(ws + OFF_VT), (bf16_t*)(ws + OFF_GVT), rope, lnsum, lnsq};
        pg8::gemm_phase(lds, g2, s2, e2);
    }
    grid.sync();
    if (PHMASK & 4) for (int item = c; item < 256; item += G) retention_prompt(P, lds, item);
    if (PHMASK & 256) for (int item = c; item < 512; item += G) retention_sample(P, lds, item);
    if (PHMASK & 512) for (int item = c; item < 512; item += G) gmlp_prompt(P, lds, item);
    if (PHMASK & 1024) gmlp_sample(P);
    grid.sync();
    if (PHMASK & 8) {
        pg8::Order s; s.init(MP, 1024, G, c);
        pg8::Gemm g1{(const bf16_t*)(ws + OFF_RO), (const bf16_t*)(ws + OFF_WRET), MP, 1024, 2048};
        EpiRet e1{sso, (const bf16_t*)(ws + OFF_AR), (float*)(ws + OFF_T1)};
        pg8::gemm_phase(lds, g1, s, e1);
        pg8::Gemm g2{(const bf16_t*)(ws + OFF_GI), (const bf16_t*)(ws + OFF_WGM), MP, 1024, 1024};
        EpiGm e2{(const float*)(ws + OFF_T1), (const bf16_t*)(ws + OFF_AG), (bf16_t*)(ws + OFF_MM)};
        pg8::gemm_phase(lds, g2, s, e2);
    }
    grid.sync();
    if (PHMASK & 16) {
        pg8::Order s; s.init(MP, 1024, G, c);
        pg8::Gemm g{(const bf16_t*)(ws + OFF_MM), (const bf16_t*)(ws + OFF_WO), MP, 1024, 1024};
        EpiO e{P.in[0], P.in[1], (float*)(ws + OFF_H), (bf16_t*)(ws + OFF_HB), ssh};
        pg8::gemm_phase(lds, g, s, e);
    }
    grid.sync();
    if (PHMASK & 32) {
        pg8::Order s; s.init(MP, 5632, G, c);
        pg8::Gemm g{(const bf16_t*)(ws + OFF_HB), (const bf16_t*)(ws + OFF_WF1), MP, 5632, 1024};
        EpiF1 e{ssh, (bf16_t*)(ws + OFF_ACT)};
        pg8::gemm_phase(lds, g, s, e);
    }
    grid.sync();
    if (PHMASK & 64) {
        pg8::Order s; s.init(MP, 1024, G, c);
        pg8::Gemm g{(const bf16_t*)(ws + OFF_ACT), (const bf16_t*)(ws + OFF_WF2), MP, 1024, 2816};
        EpiF2 e{(const float*)(ws + OFF_H), P.out + OUT_Y, ssh2};
        pg8::gemm_phase(lds, g, s, e);
    }
    grid.sync();
    if (PHMASK & 128) final_norm(P);
}

extern "C" void kernel_launch(void* const* d_in, const int* in_sizes, int n_in, void* d_out, int out_size, void* d_ws, size_t ws_size, hipStream_t stream) {
    static int grid_blocks = 0;
    if (!grid_blocks) {
        int dev = 0, cus = 0, per_cu = 0;
        hipGetDevice(&dev);
        hipDeviceGetAttribute(&cus, hipDeviceAttributeMultiprocessorCount, dev);
        hipFuncSetAttribute((const void*)fwd_megakernel, hipFuncAttributeMaxDynamicSharedMemorySize, LDS_BYTES);
        hipOccupancyMaxActiveBlocksPerMultiprocessor(&per_cu, (const void*)fwd_megakernel, 512, LDS_BYTES);
        if (per_cu < 1) per_cu = 1;
        if (cus < 1) cus = 256;
        grid_blocks = cus * per_cu;
        if (ws_size < WS_END) fprintf(stderr, "kernel_launch: workspace too small: %zu < %zu\n", ws_size, (size_t)WS_END);
    }
    Params p{};
    for (int i = 0; i < 16; ++i) p.in[i] = (const float*)d_in[i];
    p.out = (float*)d_out; p.ws = (unsigned char*)d_ws;
    void* args[] = {&p};
    hipError_t e = hipLaunchCooperativeKernel((const void*)fwd_megakernel, dim3(grid_blocks), dim3(512), args, LDS_BYTES, stream);
    if (e != hipSuccess) fprintf(stderr, "cooperative launch failed: %s (grid %d)\n", hipGetErrorString(e), grid_blocks);
}
```

```cpp
#include <hip/hip_runtime.h>
#include <hip/hip_cooperative_groups.h>
#include <cstdio>
namespace cg = cooperative_groups;

#define LAS __attribute__((address_space(3)))
#define DI __device__ __forceinline__
typedef unsigned short bf16_t;
typedef short bf16x8 __attribute__((ext_vector_type(8)));
typedef float f32x4 __attribute__((ext_vector_type(4)));
typedef float f32x2 __attribute__((ext_vector_type(2)));
typedef float f32x16 __attribute__((ext_vector_type(16)));
typedef unsigned u32x4 __attribute__((ext_vector_type(4)));
typedef unsigned u32x2 __attribute__((ext_vector_type(2)));
typedef LAS unsigned char* ldsp;

constexpr int NP = 16384, NSAMP = 128, MR = NP + NSAMP, MP = 16640;
constexpr int LDS_BYTES = 147456;
constexpr float EPSF = 1e-6f;

constexpr size_t SZ_MP1024_BF = (size_t)MP * 1024 * 2;
constexpr size_t OFF_XN = 0;
constexpr size_t OFF_WT1 = OFF_XN + SZ_MP1024_BF;
constexpr size_t OFF_WT2 = OFF_WT1 + (size_t)7168 * 1024 * 2;
constexpr size_t OFF_WRET = OFF_WT2 + (size_t)4096 * 1024 * 2;
constexpr size_t OFF_WGM = OFF_WRET + (size_t)1024 * 2048 * 2;
constexpr size_t OFF_WO = OFF_WGM + (size_t)1024 * 1024 * 2;
constexpr size_t OFF_WF1 = OFF_WO + (size_t)1024 * 1024 * 2;
constexpr size_t OFF_WF2 = OFF_WF1 + (size_t)5632 * 1024 * 2;
constexpr size_t OFF_Q = OFF_WF2 + (size_t)1024 * 2816 * 2;
constexpr size_t OFF_K = OFF_Q + SZ_MP1024_BF;
constexpr size_t OFF_SG = OFF_K + SZ_MP1024_BF;
constexpr size_t OFF_GU = OFF_SG + 2 * SZ_MP1024_BF;
constexpr size_t OFF_AR = OFF_GU + SZ_MP1024_BF;
constexpr size_t OFF_AG = OFF_AR + SZ_MP1024_BF;
constexpr size_t OFF_KT = OFF_AG + SZ_MP1024_BF;
constexpr size_t OFF_VT = OFF_KT + SZ_MP1024_BF;
constexpr size_t OFF_GVT = OFF_VT + 2 * SZ_MP1024_BF;
constexpr size_t OFF_RO = OFF_GVT + SZ_MP1024_BF;
constexpr size_t OFF_GI = OFF_RO + 2 * SZ_MP1024_BF;
constexpr size_t OFF_T1 = OFF_GI + SZ_MP1024_BF;
constexpr size_t OFF_MM = OFF_T1 + 2 * SZ_MP1024_BF;
constexpr size_t OFF_H = OFF_MM + SZ_MP1024_BF;
constexpr size_t OFF_HB = OFF_H + 2 * SZ_MP1024_BF;
constexpr size_t OFF_ACT = OFF_HB + SZ_MP1024_BF;
constexpr size_t OFF_ST = OFF_ACT + (size_t)MP * 2816 * 2;
constexpr size_t OFF_ROPE = OFF_ST + (size_t)MP * 8 * 4;
constexpr size_t OFF_BAR = OFF_ROPE + (size_t)2049 * 128 * 8;
constexpr size_t OFF_STG = OFF_BAR + 16384;
constexpr size_t OFF_ACC = OFF_STG + (size_t)32 * 16 * 512 * 256 * 2;
constexpr size_t WS_END = OFF_ACC + (size_t)27 * 128 * 1024 * 4;

constexpr size_t OUT_Y = 0;
constexpr size_t OUT_SP = (size_t)MR * 1024;
constexpr size_t OUT_SS = OUT_SP + (size_t)8 * 4 * 256 * 512;
constexpr size_t OUT_GV = OUT_SS + (size_t)128 * 4 * 256 * 512;

struct Params {
    const float* in[16];
    float* out;
    unsigned char* ws;
};

DI unsigned cvt_pk_bf16(float lo, float hi) { unsigned r; asm("v_cvt_pk_bf16_f32 %0, %1, %2" : "=v"(r) : "v"(lo), "v"(hi)); return r; }
DI float bf_lo(unsigned v) { return __uint_as_float(v << 16); }
DI float bf_hi(unsigned v) { return __uint_as_float(v & 0xffff0000u); }
DI float bf2f(bf16_t b) { return __uint_as_float(((unsigned)b) << 16); }
DI bf16_t f2bf(float f) { return (bf16_t)(cvt_pk_bf16(f, 0.f) & 0xffffu); }
DI u32x4 pack8(const float* v) { u32x4 p; p[0] = cvt_pk_bf16(v[0], v[1]); p[1] = cvt_pk_bf16(v[2], v[3]); p[2] = cvt_pk_bf16(v[4], v[5]); p[3] = cvt_pk_bf16(v[6], v[7]); return p; }
DI void unpack8(u32x4 p, float* v) { v[0] = bf_lo(p[0]); v[1] = bf_hi(p[0]); v[2] = bf_lo(p[1]); v[3] = bf_hi(p[1]); v[4] = bf_lo(p[2]); v[5] = bf_hi(p[2]); v[6] = bf_lo(p[3]); v[7] = bf_hi(p[3]); }
DI float fsigmoid(float x) { return __builtin_amdgcn_rcpf(1.f + __expf(-x)); }
DI float fsilu(float x) { return x * fsigmoid(x); }
DI float fgelu(float x) { const float u = 0.7978845608028654f * (x + 0.044715f * x * x * x); return x * fsigmoid(2.f * u); }
DI int opaque_tid(int wb) { int t = wb + (int)__builtin_amdgcn_mbcnt_hi(~0u, __builtin_amdgcn_mbcnt_lo(~0u, 0u)); asm volatile("" : "+v"(t)); return t; }
#define MFMA32(a, b, c) __builtin_amdgcn_mfma_f32_32x32x16_bf16((a), (b), (c), 0, 0, 0)

template <int M> DI float shx(float v) {
    if constexpr (M < 32) return __int_as_float(__builtin_amdgcn_ds_swizzle(__float_as_int(v), (M << 10) | 0x1f));
    else { int l = (int)__builtin_amdgcn_mbcnt_hi(~0u, __builtin_amdgcn_mbcnt_lo(~0u, 0u)); asm volatile("" : "+v"(l));
           return __int_as_float(__builtin_amdgcn_ds_bpermute((l ^ 32) << 2, __float_as_int(v))); }
}
DI float sum_x15(float v) { v += shx<1>(v); v += shx<2>(v); v += shx<4>(v); v += shx<8>(v); return v; }
DI float sum_x31(float v) { v = sum_x15(v); v += shx<16>(v); return v; }
DI float sum_x63(float v) { v = sum_x31(v); v += shx<32>(v); return v; }

DI size_t kf_idx(int tok, int h, int d) { const int cg = tok >> 7, s = tok & 127, d8 = d >> 3;
    return ((((((size_t)(cg * 4 + h) * 4 + (s >> 5)) * 16 + (d8 >> 1)) * 2 + (d8 & 1)) * 32 + (s & 31)) * 8) + (d & 7); }
DI size_t ktf_idx(int tok, int h, int dk) { const int cg = tok >> 7, s = tok & 127, s8 = s >> 3;
    return ((((((size_t)(cg * 4 + h) * 8 + (dk >> 5)) * 8 + (s8 >> 1)) * 2 + (s8 & 1)) * 32 + (dk & 31)) * 8) + (s & 7); }
DI size_t vf_idx(int tok, int h, int dv) { const int cg = tok >> 7, s = tok & 127, s8 = s >> 3;
    return ((((((size_t)(cg * 4 + h) * 16 + (dv >> 5)) * 8 + (s8 >> 1)) * 2 + (s8 & 1)) * 32 + (dv & 31)) * 8) + (s & 7); }

namespace pg8 {
constexpr int BM = 256, BK = 64, HALF = 128, HTB = HALF * BK * 2, STAGE_BYTES = 8 * HTB, NXCD = 8, WGM = 8;
DI int lds_byte(int r, int c) { const int st = (r >> 4) * 2 + (c >> 5), rr = r & 15, cc = c & 31, ob = rr * 64 + cc * 2; return st * 1024 + (ob ^ (((ob >> 9) & 1) << 5)); }
DI void stage_rc(int b, int& R, int& C) { const int st = b / 1024, sb = b % 1024, swz = sb ^ (((sb >> 9) & 1) << 5); R = (st >> 1) * 16 + swz / 64; C = (st & 1) * 32 + (swz % 64) / 2; }
DI int perm32(int rho) { const int n = rho >> 4, i = rho & 15; return 8 * (i >> 2) + 4 * n + (i & 3); }
struct Unit { int pm, pn, pk; };
struct Gemm { const bf16_t* A; const bf16_t* Bt; int M, N, K, lda, ldb; };
struct Order {
    int nM, nN, nwg, G, c;
    DI void init(int M, int N, int G_, int c_) { nM = M / BM; nN = N / BM; nwg = nM * nN; G = G_; c = c_; }
    DI bool next(int i, Unit& u) const {
        const long L = (long)i * G + c; if (L >= nwg) return false;
        int wgid = (int)L; { const int q = nwg / NXCD, r = nwg % NXCD, xcd = wgid % NXCD, off = wgid / NXCD; wgid = (xcd < r ? xcd * (q + 1) : r * (q + 1) + (xcd - r) * q) + off; }
        const int nig = WGM * nN, gid = wgid / nig, fm = gid * WGM, gsz = (nM - fm) < WGM ? (nM - fm) : WGM;
        u.pm = fm + ((wgid % nig) % gsz); u.pn = (wgid % nig) / gsz; u.pk = 0; return true;
    }
};
struct SplitOrder {
    int nunits, G, c, pm;
    DI void init(int pm_, int nsplit, int G_, int c_) { pm = pm_; nunits = 4 * nsplit; G = G_; c = c_; }
    DI bool next(int i, Unit& u) const { const int L = i * G + c; if (L >= nunits) return false; u.pm = pm; u.pn = L & 3; u.pk = L >> 2; return true; }
};

template <class Epi, class Sched>
DI void gemm_phase(ldsp lds, const Gemm g, const Sched& S, const Epi& E, int wb) {
    const int tid = opaque_tid(wb), wid = __builtin_amdgcn_readfirstlane(tid >> 6), lane = tid & 63, wr = wid >> 2, wc = wid & 3, fr = lane & 15, fq = lane >> 4;
    const int K = g.K, nt = K / BK;
    unsigned voffA[2], voffB[2];
#pragma unroll
    for (int i = 0; i < 2; ++i) { int R, C; stage_rc(tid * 16 + i * 8192, R, C); const int Rb = Epi::PERM ? ((R & ~31) + perm32(R & 31)) : R;
        voffA[i] = (unsigned)(R * g.lda + C) * 2u; voffB[i] = (unsigned)(Rb * g.ldb + C) * 2u; }
    const size_t kstep = (size_t)(BK * 2);
    const size_t hstepA = (size_t)HALF * g.lda * 2, hstepB = (size_t)HALF * g.ldb * 2;
    const size_t tstepA = 2 * hstepA, tstepB = 2 * hstepB, kslice = (size_t)K * 2;
    const unsigned ldsw = (unsigned)wid * 1024u;
    const int aoff = lds_byte(wr * 64 + fr, fq * 8), boff = lds_byte(wc * 32 + fr, fq * 8);
#define PG8_SA(b, h) (((b) * 2 + (h)) * HTB)
#define PG8_SB(b, h) ((4 + (b) * 2 + (h)) * HTB)
#define PG8_STAGE(bufoff, gbase, voff) do { _Pragma("unroll") for (int _i = 0; _i < 2; ++_i) \
        __builtin_amdgcn_global_load_lds((const unsigned*)((const char*)(gbase) + (voff)[_i]), (LAS unsigned*)(lds + (bufoff) + ldsw + _i * 8192), 16, 0, 0); } while (0)
#define PG8_LDA(dst, b, h) do { _Pragma("unroll") for (int m = 0; m < 4; ++m) _Pragma("unroll") for (int k = 0; k < 2; ++k) dst[m][k] = *(const LAS bf16x8*)(lds + PG8_SA(b, h) + aoff + m * 2048 + k * 1024); } while (0)
#define PG8_LDB(dst, b, h) do { _Pragma("unroll") for (int n = 0; n < 2; ++n) _Pragma("unroll") for (int k = 0; k < 2; ++k) dst[n][k] = *(const LAS bf16x8*)(lds + PG8_SB(b, h) + boff + n * 2048 + k * 1024); } while (0)
#define PG8_MMA(ai, bj, At, Bt) do { __builtin_amdgcn_s_setprio(1); _Pragma("unroll") for (int m = 0; m < 4; ++m) _Pragma("unroll") for (int n = 0; n < 2; ++n) _Pragma("unroll") for (int k = 0; k < 2; ++k) \
        acc[ai][bj][m][n] = __builtin_amdgcn_mfma_f32_16x16x32_bf16(Bt[n][k], At[m][k], acc[ai][bj][m][n], 0, 0, 0); __builtin_amdgcn_s_setprio(0); } while (0)
#define PG8_WAIT_V(n) asm volatile("s_waitcnt vmcnt(" #n ")" ::: "memory")
#define PG8_WAIT_L(n) asm volatile("s_waitcnt lgkmcnt(" #n ")" ::: "memory")
#define PG8_BAR __builtin_amdgcn_s_barrier()
#define PG8_SCHED __builtin_amdgcn_sched_barrier(0)
    Unit cur, nxt; int ui = 0;
    if (!S.next(0, cur)) return;
    f32x4 acc[2][2][4][2];
#pragma unroll
    for (int a = 0; a < 2; ++a)
#pragma unroll
        for (int b = 0; b < 2; ++b)
#pragma unroll
            for (int m = 0; m < 4; ++m)
#pragma unroll
                for (int n = 0; n < 2; ++n) acc[a][b][m][n] = (f32x4){0.f, 0.f, 0.f, 0.f};
    bf16x8 At[4][2], B0[2][2], B1[2][2];
    const char* cA = (const char*)g.A + (size_t)cur.pm * tstepA + (size_t)cur.pk * kslice; const char* cB = (const char*)g.Bt + (size_t)cur.pn * tstepB + (size_t)cur.pk * kslice;
    PG8_STAGE(PG8_SB(0, 0), cB, voffB); PG8_STAGE(PG8_SA(0, 0), cA, voffA); PG8_STAGE(PG8_SB(0, 1), cB + hstepB, voffB); PG8_STAGE(PG8_SA(0, 1), cA + hstepA, voffA);
    if (wr == 1) PG8_BAR;
    PG8_WAIT_V(4); PG8_BAR;
    PG8_STAGE(PG8_SB(1, 0), cB + kstep, voffB); PG8_STAGE(PG8_SA(1, 0), cA + kstep, voffA); PG8_STAGE(PG8_SB(1, 1), cB + hstepB + kstep, voffB);
    PG8_WAIT_V(6); PG8_BAR;
    for (;;) {
        const bool has_next = S.next(ui + 1, nxt);
        const char* nA = has_next ? (const char*)g.A + (size_t)nxt.pm * tstepA + (size_t)nxt.pk * kslice : cA; const char* nB = has_next ? (const char*)g.Bt + (size_t)nxt.pn * tstepB + (size_t)nxt.pk * kslice : cB;
        for (int t = 0; t < nt; t += 2) {
            const bool last = (t == nt - 2);
            const char* a1 = cA + (size_t)(t + 1) * kstep;
            const char* a2 = last ? nA : cA + (size_t)(t + 2) * kstep; const char* b2 = last ? nB : cB + (size_t)(t + 2) * kstep;
            const char* a3 = a2 + kstep; const char* b3 = b2 + kstep;
            PG8_LDB(B0, 0, 0); PG8_SCHED; PG8_LDA(At, 0, 0); PG8_STAGE(PG8_SA(1, 1), a1 + hstepA, voffA);
            PG8_WAIT_L(8); PG8_BAR; PG8_WAIT_L(0); PG8_MMA(0, 0, At, B0); PG8_BAR; PG8_SCHED;
            PG8_LDB(B1, 0, 1); PG8_STAGE(PG8_SB(0, 0), b2, voffB);
            PG8_BAR; PG8_WAIT_L(0); PG8_MMA(0, 1, At, B1); PG8_BAR;
            PG8_LDA(At, 0, 1); PG8_STAGE(PG8_SA(0, 0), a2, voffA);
            PG8_BAR; PG8_WAIT_L(0); PG8_MMA(1, 0, At, B0); PG8_BAR; PG8_SCHED;
            PG8_STAGE(PG8_SB(0, 1), b2 + hstepB, voffB);
            PG8_WAIT_V(6); PG8_BAR; PG8_MMA(1, 1, At, B1); PG8_BAR;
            PG8_LDB(B0, 1, 0); PG8_SCHED; PG8_LDA(At, 1, 0); PG8_STAGE(PG8_SA(0, 1), a2 + hstepA, voffA);
            PG8_WAIT_L(8); PG8_BAR; PG8_WAIT_L(0); PG8_MMA(0, 0, At, B0); PG8_BAR; PG8_SCHED;
            PG8_LDB(B1, 1, 1); PG8_STAGE(PG8_SB(1, 0), b3, voffB);
            PG8_BAR; PG8_WAIT_L(0); PG8_MMA(0, 1, At, B1); PG8_BAR;
            PG8_LDA(At, 1, 1); PG8_STAGE(PG8_SA(1, 0), a3, voffA);
            PG8_BAR; PG8_WAIT_L(0); PG8_MMA(1, 0, At, B0); PG8_BAR; PG8_SCHED;
            PG8_STAGE(PG8_SB(1, 1), b3 + hstepB, voffB);
            PG8_WAIT_V(6); PG8_BAR; PG8_MMA(1, 1, At, B1); PG8_BAR;
            if constexpr (Epi::KHOOK) { if (t + 2 == Epi::KHOOK_AT) { int fr2 = fr, fq2 = fq; asm volatile("" : "+v"(fr2), "+v"(fq2)); E.khook(acc, cur, t, wr, wc, fr2, fq2); } }
        }
        { int fr2 = fr, fq2 = fq; asm volatile("" : "+v"(fr2), "+v"(fq2));
          E(acc, cur, wr, wc, fr2, fq2); }
        if (!has_next) break;
#pragma unroll
        for (int a = 0; a < 2; ++a)
#pragma unroll
            for (int b = 0; b < 2; ++b)
#pragma unroll
                for (int m = 0; m < 4; ++m)
#pragma unroll
                    for (int n = 0; n < 2; ++n) acc[a][b][m][n] = (f32x4){0.f, 0.f, 0.f, 0.f};
        cur = nxt; cA = nA; cB = nB; ++ui;
    }
    PG8_WAIT_V(0);
    if (wr == 0) PG8_BAR;
    PG8_BAR;
#undef PG8_SA
#undef PG8_SB
#undef PG8_STAGE
#undef PG8_LDA
#undef PG8_LDB
#undef PG8_MMA
#undef PG8_WAIT_V
#undef PG8_WAIT_L
#undef PG8_BAR
#undef PG8_SCHED
}
}
using pg8::Unit;
typedef f32x4 Acc[2][2][4][2];
#define EPI_UNROLL _Pragma("unroll")
DI void acc8(const Acc& acc, int ai, int bj, int m, float* v) {
    v[0] = acc[ai][bj][m][0][0]; v[1] = acc[ai][bj][m][0][1]; v[2] = acc[ai][bj][m][0][2]; v[3] = acc[ai][bj][m][0][3];
    v[4] = acc[ai][bj][m][1][0]; v[5] = acc[ai][bj][m][1][1]; v[6] = acc[ai][bj][m][1][2]; v[7] = acc[ai][bj][m][1][3];
}

struct EpiIn1 {
    static constexpr bool PERM = true, KHOOK = false;
    unsigned char* ws; const float* rope;
    DI void operator()(const Acc& acc, const Unit& u, int wr, int wc, int fr, int fq) const {
        const int pn = u.pn, row0 = u.pm * 256 + wr * 64 + fr, cl = wc * 32 + 8 * fq;
        if (pn < 4) {
            bf16_t* dst = (bf16_t*)(ws + OFF_Q); const int cb = pn * 256;
            f32x4 cr[4], nr[4];
            { const int row = row0, pidx = row < NP ? (row & 2047) : 2048; const f32x4* rp = (const f32x4*)(rope + ((size_t)pidx * 128 + cl) * 2);
              EPI_UNROLL for (int q = 0; q < 4; ++q) cr[q] = rp[q]; }
            EPI_UNROLL for (int it = 0; it < 8; ++it) { const int ai = it >> 2, m = it & 3; const int row = row0 + ai * 128 + m * 16;
                if (it < 7) { const int nrow = row0 + ((it + 1) >> 2) * 128 + ((it + 1) & 3) * 16, pidx = nrow < NP ? (nrow & 2047) : 2048;
                    const f32x4* rp = (const f32x4*)(rope + ((size_t)pidx * 128 + cl) * 2);
                    EPI_UNROLL for (int q = 0; q < 4; ++q) nr[q] = rp[q]; }
                float x1[8], x2[8], o1[8], o2[8]; acc8(acc, ai, 0, m, x1); acc8(acc, ai, 1, m, x2);
                EPI_UNROLL for (int q = 0; q < 4; ++q) { const f32x4 cs = cr[q];
                    o1[2 * q] = x1[2 * q] * cs[0] - x2[2 * q] * cs[1]; o2[2 * q] = x1[2 * q] * cs[1] + x2[2 * q] * cs[0];
                    o1[2 * q + 1] = x1[2 * q + 1] * cs[2] - x2[2 * q + 1] * cs[3]; o2[2 * q + 1] = x1[2 * q + 1] * cs[3] + x2[2 * q + 1] * cs[2]; }
                bf16_t* rowp = dst + (size_t)row * 1024 + cb + cl; *(u32x4*)rowp = pack8(o1); *(u32x4*)(rowp + 128) = pack8(o2);
                EPI_UNROLL for (int q = 0; q < 4; ++q) cr[q] = nr[q];
                __builtin_amdgcn_sched_barrier(0);
            }
        } else {
            size_t doff; int ld, cb, mode;
            if (pn < 12) { doff = OFF_SG; ld = 2048; cb = (pn - 4) * 256; mode = 0; }
            else if (pn < 16) { doff = OFF_GU; ld = 1024; cb = (pn - 12) * 256; mode = 1; }
            else if (pn < 20) { doff = OFF_AR; ld = 1024; cb = (pn - 16) * 256; mode = 2; }
            else { doff = OFF_AG; ld = 1024; cb = (pn - 20) * 256; mode = 2; }
            bf16_t* dst = (bf16_t*)(ws + doff);
            EPI_UNROLL for (int ai = 0; ai < 2; ++ai) EPI_UNROLL for (int m = 0; m < 4; ++m) {
                const int row = row0 + ai * 128 + m * 16;
                EPI_UNROLL for (int bj = 0; bj < 2; ++bj) { float v[8]; acc8(acc, ai, bj, m, v);
                    if (mode == 0) { EPI_UNROLL for (int e = 0; e < 8; ++e) v[e] = fsilu(v[e]); }
                    else if (mode == 1) { EPI_UNROLL for (int e = 0; e < 8; ++e) v[e] = fgelu(v[e]); }
                    else { EPI_UNROLL for (int e = 0; e < 8; ++e) v[e] = fsigmoid(v[e]); }
                    *(u32x4*)(dst + (size_t)row * ld + cb + bj * 128 + cl) = pack8(v); }
            }
        }
    }
};
struct EpiIn2 {
    static constexpr bool PERM = true, KHOOK = false;
    bf16_t *KT, *VT, *GVT, *KF; const float* rope; float *lnsum, *lnsq;
    DI void operator()(const Acc& acc, const Unit& u, int wr, int wc, int fr, int fq) const {
        const int pm = u.pm, tl = wc * 32 + 8 * fq;
        if (pm < 4) {
            f32x2 cs[8], ns[8];
            { const int tok = u.pn * 256 + tl, j = wr * 64 + fr; const int pbase = tok < NP ? (tok & 2047) : 2048, pinc = tok < NP ? 1 : 0;
              EPI_UNROLL for (int e = 0; e < 8; ++e) cs[e] = *(const f32x2*)(rope + ((size_t)(pbase + pinc * e) * 128 + j) * 2); }
            EPI_UNROLL for (int it = 0; it < 8; ++it) { const int m = it >> 1, bj = it & 1; const int j = wr * 64 + m * 16 + fr; const int tok = u.pn * 256 + bj * 128 + tl;
                if (it < 7) { const int nm = (it + 1) >> 1, nb = (it + 1) & 1; const int nj = wr * 64 + nm * 16 + fr, ntok = u.pn * 256 + nb * 128 + tl;
                    const int pbase = ntok < NP ? (ntok & 2047) : 2048, pinc = ntok < NP ? 1 : 0;
                    EPI_UNROLL for (int e = 0; e < 8; ++e) ns[e] = *(const f32x2*)(rope + ((size_t)(pbase + pinc * e) * 128 + nj) * 2); }
                EPI_UNROLL for (int hf = 0; hf < 2; ++hf) {
                    float x1[8], x2[8], o[8]; acc8(acc, 0, bj, m, x1); acc8(acc, 1, bj, m, x2);
                    EPI_UNROLL for (int e = 0; e < 8; ++e) o[e] = (hf == 0 ? (x1[e] * cs[e][0] - x2[e] * cs[e][1]) : (x1[e] * cs[e][1] + x2[e] * cs[e][0])) * 0.0625f;
                    *(u32x4*)(KT + ktf_idx(tok, pm, hf * 128 + j)) = pack8(o);
#define TR_STAGE(KK) { const bool up = (fr & KK) != 0; EPI_UNROLL for (int e = 0; e < 8; ++e) { if ((e & KK) == 0) { \
                        const float a = o[e], b = o[e ^ KK]; const float rcv = shx<KK>(up ? a : b); o[e] = up ? rcv : a; o[e ^ KK] = up ? b : rcv; } } }
                    TR_STAGE(4) TR_STAGE(2) TR_STAGE(1)
#undef TR_STAGE
                    *(u32x4*)(KF + kf_idx(tok + (fr & 7), pm, hf * 128 + wr * 64 + m * 16 + (fr & 8))) = pack8(o); }
                EPI_UNROLL for (int e = 0; e < 8; ++e) cs[e] = ns[e];
                __builtin_amdgcn_sched_barrier(0); }
        } else if (pm < 12) {
            EPI_UNROLL for (int ai = 0; ai < 2; ++ai) EPI_UNROLL for (int m = 0; m < 4; ++m) { const int r = (pm - 4) * 256 + ai * 128 + wr * 64 + m * 16 + fr;
                EPI_UNROLL for (int bj = 0; bj < 2; ++bj) { float v[8]; acc8(acc, ai, bj, m, v);
                    *(u32x4*)(VT + vf_idx(u.pn * 256 + bj * 128 + tl, r >> 9, r & 511)) = pack8(v); } }
        } else {
            EPI_UNROLL for (int bj = 0; bj < 2; ++bj) {
                float s1[8], s2[8];
                EPI_UNROLL for (int e = 0; e < 8; ++e) { s1[e] = 0.f; s2[e] = 0.f; }
                EPI_UNROLL for (int ai = 0; ai < 2; ++ai) EPI_UNROLL for (int m = 0; m < 4; ++m) { const int r = (pm - 12) * 256 + ai * 128 + wr * 64 + m * 16 + fr;
                    float v[8]; acc8(acc, ai, bj, m, v);
                    EPI_UNROLL for (int e = 0; e < 8; ++e) { v[e] = fgelu(v[e]); s1[e] += v[e]; s2[e] += v[e] * v[e]; }
                    *(u32x4*)(GVT + (size_t)r * MP + u.pn * 256 + bj * 128 + tl) = pack8(v); __builtin_amdgcn_sched_barrier(0); }
                EPI_UNROLL for (int e = 0; e < 8; ++e) {
                    float a = s1[e], b = s2[e];
                    a = sum_x15(a); b = sum_x15(b);
                    if (fr == 0) { const int tok = u.pn * 256 + bj * 128 + tl + e; unsafeAtomicAdd(lnsum + tok, a); unsafeAtomicAdd(lnsq + tok, b); } }
                __builtin_amdgcn_sched_barrier(0);
            }
        }
    }
};
struct EpiMerge {
    static constexpr bool PERM = true, KHOOK = true; static constexpr int KHOOK_AT = 32;
    const bf16_t* AR; const bf16_t* AG; bf16_t* MM;
    DI void khook(Acc& acc, const Unit& u, int t, int wr, int wc, int fr, int fq) const {
        const size_t base = (size_t)(u.pm * 256 + wr * 64 + fr) * 1024 + u.pn * 256 + wc * 32 + 8 * fq;
        EPI_UNROLL for (int it = 0; it < 8; ++it) { const int ai = it >> 2, m = it & 3; const size_t off = base + (size_t)(ai * 128 + m * 16) * 1024;
            EPI_UNROLL for (int bj = 0; bj < 2; ++bj) { float a[8], g[8]; unpack8(*(const u32x4*)(AR + off + bj * 128), a); unpack8(*(const u32x4*)(AG + off + bj * 128), g);
                EPI_UNROLL for (int e = 0; e < 4; ++e) { acc[ai][bj][m][0][e] *= a[e] * __builtin_amdgcn_rcpf(fmaxf(g[e], 1e-20f)); acc[ai][bj][m][1][e] *= a[4 + e] * __builtin_amdgcn_rcpf(fmaxf(g[4 + e], 1e-20f)); } }
            __builtin_amdgcn_sched_barrier(0); }
    }
    DI void operator()(const Acc& acc, const Unit& u, int wr, int wc, int fr, int fq) const {
        const size_t base = (size_t)(u.pm * 256 + wr * 64 + fr) * 1024 + u.pn * 256 + wc * 32 + 8 * fq;
        u32x4 cg[2], ng[2];
        cg[0] = *(const u32x4*)(AG + base); cg[1] = *(const u32x4*)(AG + base + 128);
        EPI_UNROLL for (int it = 0; it < 8; ++it) { const int ai = it >> 2, m = it & 3; const size_t off = base + (size_t)(ai * 128 + m * 16) * 1024;
            if (it < 7) { const size_t no = base + (size_t)(((it + 1) >> 2) * 128 + ((it + 1) & 3) * 16) * 1024; ng[0] = *(const u32x4*)(AG + no); ng[1] = *(const u32x4*)(AG + no + 128); }
            EPI_UNROLL for (int bj = 0; bj < 2; ++bj) { float v[8], g[8]; acc8(acc, ai, bj, m, v); unpack8(cg[bj], g);
                EPI_UNROLL for (int e = 0; e < 8; ++e) v[e] *= fmaxf(g[e], 1e-20f);
                *(u32x4*)(MM + off + bj * 128) = pack8(v); }
            cg[0] = ng[0]; cg[1] = ng[1]; __builtin_amdgcn_sched_barrier(0); }
    }
};
struct EpiO {
    static constexpr bool PERM = true, KHOOK = false;
    const float *xp, *xs; float* H; bf16_t* HB; float* ssh;
    DI void operator()(const Acc& acc, const Unit& u, int wr, int wc, int fr, int fq) const {
        const int row0 = u.pm * 256 + wr * 64 + fr;
        const size_t base = (size_t)row0 * 1024 + u.pn * 256 + wc * 32 + 8 * fq;
        f32x4 cx[4], nx[4];
        EPI_UNROLL for (int bj = 0; bj < 2; ++bj) { cx[2 * bj] = *(const f32x4*)(xp + base + bj * 128); cx[2 * bj + 1] = *(const f32x4*)(xp + base + bj * 128 + 4); }
        EPI_UNROLL for (int it = 0; it < 8; ++it) { const int ai = it >> 2, m = it & 3; const size_t off = base + (size_t)(ai * 128 + m * 16) * 1024;
            if (it < 7) { const size_t no = base + (size_t)(((it + 1) >> 2) * 128 + ((it + 1) & 3) * 16) * 1024;
                EPI_UNROLL for (int bj = 0; bj < 2; ++bj) { nx[2 * bj] = *(const f32x4*)(xp + no + bj * 128); nx[2 * bj + 1] = *(const f32x4*)(xp + no + bj * 128 + 4); } }
            float ss = 0.f;
            EPI_UNROLL for (int bj = 0; bj < 2; ++bj) { float v[8]; acc8(acc, ai, bj, m, v);
                EPI_UNROLL for (int e = 0; e < 4; ++e) { v[e] += cx[2 * bj][e]; v[4 + e] += cx[2 * bj + 1][e]; }
                EPI_UNROLL for (int e = 0; e < 8; ++e) ss += v[e] * v[e];
                *(u32x4*)(HB + off + bj * 128) = pack8(v); }
            ss += shx<16>(ss); ss += shx<32>(ss);
            if (fq == 0) unsafeAtomicAdd(ssh + row0 + ai * 128 + m * 16, ss);
            EPI_UNROLL for (int q = 0; q < 4; ++q) cx[q] = nx[q];
            __builtin_amdgcn_sched_barrier(0); }
    }
};
struct EpiF1 {
    static constexpr bool PERM = true, KHOOK = false;
    const float* ssh; bf16_t* ACT;
    DI void operator()(const Acc& acc, const Unit& u, int wr, int wc, int fr, int fq) const {
        EPI_UNROLL for (int ai = 0; ai < 2; ++ai) EPI_UNROLL for (int m = 0; m < 4; ++m) { const int row = u.pm * 256 + ai * 128 + wr * 64 + m * 16 + fr;
            const float rs = rsqrtf(ssh[row] * (1.f / 1024.f) + EPSF);
            float g[8], p[8]; acc8(acc, ai, 0, m, g); acc8(acc, ai, 1, m, p);
            EPI_UNROLL for (int e = 0; e < 8; ++e) g[e] = fsilu(g[e] * rs) * (p[e] * rs);
            *(u32x4*)(ACT + (size_t)row * 2816 + u.pn * 128 + wc * 32 + 8 * fq) = pack8(g); }
    }
};
struct EpiF2 {
    static constexpr bool PERM = true, KHOOK = false;
    const bf16_t* HB; bf16_t* Y2; float* ssh2;
    DI void operator()(const Acc& acc, const Unit& u, int wr, int wc, int fr, int fq) const {
        const int row0 = u.pm * 256 + wr * 64 + fr;
        const size_t base = (size_t)row0 * 1024 + u.pn * 256 + wc * 32 + 8 * fq;
        u32x4 cx[2], nx[2];
        cx[0] = *(const u32x4*)(HB + base); cx[1] = *(const u32x4*)(HB + base + 128);
        EPI_UNROLL for (int it = 0; it < 8; ++it) { const int ai = it >> 2, m = it & 3; const size_t off = base + (size_t)(ai * 128 + m * 16) * 1024;
            if (it < 7) { const size_t no = base + (size_t)(((it + 1) >> 2) * 128 + ((it + 1) & 3) * 16) * 1024; nx[0] = *(const u32x4*)(HB + no); nx[1] = *(const u32x4*)(HB + no + 128); }
            float ss = 0.f;
            EPI_UNROLL for (int bj = 0; bj < 2; ++bj) { float v[8], h[8]; acc8(acc, ai, bj, m, v); unpack8(cx[bj], h);
                EPI_UNROLL for (int e = 0; e < 8; ++e) { v[e] += h[e]; ss += v[e] * v[e]; }
                *(u32x4*)(Y2 + off + bj * 128) = pack8(v); }
            ss += shx<16>(ss); ss += shx<32>(ss);
            if (fq == 0) unsafeAtomicAdd(ssh2 + row0 + ai * 128 + m * 16, ss);
            cx[0] = nx[0]; cx[1] = nx[1];
            __builtin_amdgcn_sched_barrier(0); }
    }
};
struct EpiSplit {
    static constexpr bool PERM = true, KHOOK = false;
    float* SLAB;
    DI void operator()(const Acc& acc, const Unit& u, int wr, int wc, int fr, int fq) const {
        float* sl = SLAB + (size_t)u.pk * 131072;
        EPI_UNROLL for (int m = 0; m < 4; ++m) { const int row = wr * 64 + m * 16 + fr;
            EPI_UNROLL for (int bj = 0; bj < 2; ++bj) { const int col = u.pn * 256 + bj * 128 + wc * 32 + 8 * fq;
                *(f32x4*)(sl + (size_t)row * 1024 + col) = acc[0][bj][m][0]; *(f32x4*)(sl + (size_t)row * 1024 + col + 4) = acc[0][bj][m][1]; } }
    }
};

DI double dpow_int(double base, int n) { double r = 1.0; for (int b = 0; b < 8; ++b) { if ((n >> b) & 1) r *= base; base *= base; } return r; }

struct WJob { const float* src; const float* ksc; bf16_t* d0; bf16_t* d1; int N, k0, n0, ldk, hi0; long r0, r1; };
DI WJob wjob_decode(const Params& P, int job) {
    WJob w; w.ksc = nullptr; w.d0 = nullptr; w.d1 = nullptr; w.hi0 = 128; w.r0 = 0; w.r1 = 0;
    int kt, ntile; unsigned char* ws = P.ws;
    if (job < 640) { w.src = P.in[4]; w.N = 10240; kt = job / 40; ntile = job % 40; w.ldk = 1024;
        const int n0 = ntile * 256, sec = n0 >> 10;
        bf16_t* W1 = (bf16_t*)(ws + OFF_WT1); bf16_t* W2 = (bf16_t*)(ws + OFF_WT2);
        if (sec == 0) { w.d0 = W1; w.r0 = n0; }
        else if (sec == 1) { w.d0 = W2; w.r0 = n0 - 1024; }
        else if (sec < 4) { w.d0 = W2; w.r0 = 1024 + (n0 - 2048); }
        else if (sec < 6) { w.d0 = W1; w.r0 = 1024 + (n0 - 4096); }
        else if (sec == 6) { w.d0 = W1; w.r0 = 3072 + (n0 - 6144); }
        else if (sec == 7) { w.d0 = W2; w.r0 = 3072 + (n0 - 7168); }
        else if (sec == 8) { w.d0 = W1; w.r0 = 4096 + (n0 - 8192); }
        else { w.d0 = W1; w.r0 = 5120 + (n0 - 9216); }
    } else if (job < 768) { const int j = job - 640; w.src = P.in[5]; w.N = 1024; kt = j / 4; ntile = j % 4; w.ldk = 3072; w.d0 = (bf16_t*)(ws + OFF_WRET); w.r0 = ntile * 256; }
    else if (job < 832) { const int j = job - 768; w.src = P.in[10]; w.N = 1024; kt = j / 4; ntile = j % 4; w.ldk = 3072; w.d0 = (bf16_t*)(ws + OFF_WRET) + 2048; w.r0 = ntile * 256; }
    else if (job < 896) { const int j = job - 832; w.src = P.in[11]; w.N = 1024; kt = j / 4; ntile = j % 4; w.ldk = 1024; w.d0 = (bf16_t*)(ws + OFF_WO); w.r0 = ntile * 256; }
    else if (job < 1248) { const int j = job - 896; w.src = P.in[13]; w.N = 5632; kt = j / 22; ntile = j % 22; w.ldk = 1024; w.d0 = (bf16_t*)(ws + OFF_WF1); w.ksc = P.in[12];
        const int n0 = ntile * 256; w.hi0 = 256; w.r0 = n0 < 2816 ? 2 * n0 : 2 * (n0 - 2816) + 128; }
    else { const int j = job - 1248; w.src = P.in[14]; w.N = 1024; kt = j / 4; ntile = j % 4; w.ldk = 2816; w.d0 = (bf16_t*)(ws + OFF_WF2); w.r0 = ntile * 256; }
    w.k0 = kt * 64; w.n0 = ntile * 256; return w;
}
DI void wjob_load(const WJob& w, int tid, f32x4 (&v)[8]) {
    const int n4 = (tid & 63) * 4, kb = tid >> 6;
#pragma unroll
    for (int i = 0; i < 8; ++i) v[i] = *(const f32x4*)(w.src + (size_t)(w.k0 + kb + 8 * i) * w.N + w.n0 + n4);
}
DI void wjob_store(const WJob& w, int tid, const f32x4 (&v)[8], ldsp lds) {
    LAS float* tile = (LAS float*)lds;
    __syncthreads();
    { const int n4 = (tid & 63) * 4, kb = tid >> 6;
#pragma unroll
      for (int i = 0; i < 8; ++i) { const int k = kb + 8 * i; const float s = w.ksc ? w.ksc[w.k0 + k] : 1.f;
          tile[k * 257 + n4] = v[i][0] * s; tile[k * 257 + n4 + 1] = v[i][1] * s; tile[k * 257 + n4 + 2] = v[i][2] * s; tile[k * 257 + n4 + 3] = v[i][3] * s; } }
    __syncthreads();
#pragma unroll
    for (int i = 0; i < 4; ++i) { const int item = tid + 512 * i, n = item >> 3, seg = item & 7;
        float o[8];
#pragma unroll
        for (int e = 0; e < 8; ++e) o[e] = tile[(seg * 8 + e) * 257 + n];
        const u32x4 p = pack8(o);
        const long rl = (n & 127) + (long)(n >> 7) * w.hi0;
        *(u32x4*)(w.d0 + (size_t)(w.r0 + rl) * w.ldk + w.k0 + seg * 8) = p;
        if (w.d1) *(u32x4*)(w.d1 + (size_t)(w.r1 + rl) * w.ldk + w.k0 + seg * 8) = p; }
}

DI void wjobs(const Params& P, ldsp lds, int tid, int first, int stride, int last) {
    int job = first;
    if (job < last) {
        WJob w = wjob_decode(P, job); f32x4 v[8]; wjob_load(w, tid, v);
        for (;;) {
            const int nj = job + stride; const bool more = nj < last;
            WJob wn = w; f32x4 vn[8];
#pragma unroll
            for (int i = 0; i < 8; ++i) vn[i] = v[i];
            if (more) { wn = wjob_decode(P, nj); wjob_load(wn, tid, vn); }
            wjob_store(w, tid, v, lds);
            if (!more) break;
            w = wn; job = nj;
#pragma unroll
            for (int i = 0; i < 8; ++i) v[i] = vn[i];
        }
    }
}

DI void phase0(const Params& P, ldsp lds, int wb) {
    const int tid = opaque_tid(wb), G = gridDim.x;
    const size_t gtid = (size_t)blockIdx.x * 512 + tid, gsz = (size_t)G * 512;
    float* st = (float*)(P.ws + OFF_ST);
    for (size_t i = gtid; i < (size_t)MP * 8; i += gsz) st[i] = 0.f;
    float* rope = (float*)(P.ws + OFF_ROPE);
    for (size_t i = gtid; i < (size_t)2049 * 128; i += gsz) { const int pidx = (int)(i >> 7), j = (int)(i & 127);
        const double inv = dpow_int(0.9305720409296989, j);
        const double pos = pidx < 2048 ? (double)pidx : 16384.0;
        double rev = pos * inv * 0.15915494309189535; rev -= floor(rev);
        const float fr = (float)rev;
        rope[2 * i] = __builtin_amdgcn_cosf(fr); rope[2 * i + 1] = __builtin_amdgcn_sinf(fr); }
    { const int wave = tid >> 6, lane = tid & 63; bf16_t* XN = (bf16_t*)(P.ws + OFF_XN); const float* g = P.in[3];
      f32x4 gg[4];
#pragma unroll
      for (int i = 0; i < 4; ++i) gg[i] = *(const f32x4*)(g + lane * 16 + i * 4);
      for (int row0 = blockIdx.x * 8 + wave; row0 < MP; row0 += G * 8 * 4) {
          f32x4 v[4][4];
#pragma unroll
          for (int q = 0; q < 4; ++q) { const int row = row0 + q * G * 8;
              const float* xr = row < NP ? P.in[0] + (size_t)row * 1024 : P.in[1] + (size_t)(row < MR ? row - NP : 0) * 1024;
#pragma unroll
              for (int i = 0; i < 4; ++i) v[q][i] = (row < MR) ? *(const f32x4*)(xr + lane * 16 + i * 4) : (f32x4){0.f, 0.f, 0.f, 0.f}; }
#pragma unroll
          for (int q = 0; q < 4; ++q) { const int row = row0 + q * G * 8;
              float ss = 0.f;
#pragma unroll
              for (int i = 0; i < 4; ++i) ss += v[q][i][0] * v[q][i][0] + v[q][i][1] * v[q][i][1] + v[q][i][2] * v[q][i][2] + v[q][i][3] * v[q][i][3];
              ss = sum_x63(ss);
              const float rs = rsqrtf(ss * (1.f / 1024.f) + EPSF);
              float o[16];
#pragma unroll
              for (int i = 0; i < 4; ++i)
#pragma unroll
                  for (int e = 0; e < 4; ++e) o[i * 4 + e] = v[q][i][e] * rs * gg[i][e];
              if (row < MP) { *(u32x4*)(XN + (size_t)row * 1024 + lane * 16) = pack8(o); *(u32x4*)(XN + (size_t)row * 1024 + lane * 16 + 8) = pack8(o + 8); } } } }
    wjobs(P, lds, tid, blockIdx.x, G, 640);
}

DI void retention_scan(const Params& P, ldsp lds, int item, int wb) {
    const int tid = opaque_tid(wb), wid = tid >> 6, lane = tid & 63, r = lane & 31, hh = lane >> 5;
    const int xcd = item & 7, idx = item >> 3, pair = xcd * 4 + (idx >> 3), dvs = idx & 7, b = pair >> 2, h = pair & 3;
    constexpr int STS = 0, GAM = 33792;
    const bf16_t* KTF = (const bf16_t*)(P.ws + OFF_KT); const bf16_t* VF = (const bf16_t*)(P.ws + OFF_VT);
    bf16_t* STG = (bf16_t*)(P.ws + OFF_STG);
    LAS float* gam = (LAS float*)(lds + GAM);
    __syncthreads();
    if (tid <= 128) gam[tid] = (float)dpow_int(1.0 - __builtin_ldexp(1.0, -5 - h), tid);
    __syncthreads();
    const int dd = wid & 1, dkt = wid >> 1;
    float dec[8][8];
#pragma unroll
    for (int ks = 0; ks < 8; ++ks)
#pragma unroll
        for (int e = 0; e < 8; ++e) dec[ks][e] = gam[127 - (ks * 16 + hh * 8 + e)];
    const float g128 = gam[128];
    f32x16 Sacc[2];
#pragma unroll
    for (int i = 0; i < 16; ++i) { Sacc[0][i] = 0.f; Sacc[1][i] = 0.f; }
    bf16x8 a0[8], a1[8]; u32x4 vt[8];
    { const size_t cgh = (size_t)((b * 16) * 4 + h);
      const bf16_t* ka = KTF + (cgh * 8 + dkt) * 4096 + lane * 8; const bf16_t* vb = VF + (cgh * 16 + dvs * 2 + dd) * 4096 + lane * 8;
#pragma unroll
      for (int i = 0; i < 8; ++i) { a0[i] = *(const bf16x8*)(ka + i * 512); a1[i] = *(const bf16x8*)(ka + 4 * 4096 + i * 512); vt[i] = *(const u32x4*)(vb + i * 512); } }
    for (int c = 0; c < 16; ++c) {
        int cg1 = b * 16 + c + 1; asm volatile("" : "+s"(cg1));
        if (c > 0) {
            __syncthreads();
#pragma unroll
            for (int hf = 0; hf < 2; ++hf)
#pragma unroll
                for (int g = 0; g < 4; ++g) { const int dk = hf * 128 + dkt * 32 + 8 * g + 4 * hh;
                    u32x2 pk; pk[0] = cvt_pk_bf16(Sacc[hf][4 * g], Sacc[hf][4 * g + 1]); pk[1] = cvt_pk_bf16(Sacc[hf][4 * g + 2], Sacc[hf][4 * g + 3]);
                    *(LAS u32x2*)(lds + STS + (dd * 32 + r) * 528 + dk * 2) = pk; }
            __syncthreads();
            bf16_t* sg = STG + (size_t)(pair * 16 + c) * 131072 + (size_t)dvs * 2 * 8192;
#pragma unroll
            for (int i = 0; i < 4; ++i) { const int it = tid + 512 * i, rr = it & 31, d8 = (it >> 5) & 31, dt = it >> 10;
                *(u32x4*)(sg + (size_t)it * 8) = *(const LAS u32x4*)(lds + STS + (dt * 32 + rr) * 528 + d8 * 16); }
        }
#pragma unroll
        for (int i = 0; i < 16; ++i) { Sacc[0][i] *= g128; Sacc[1][i] *= g128; }
        const size_t cgh = (size_t)(cg1 * 4 + h);
        const bf16_t* ka = KTF + (cgh * 8 + dkt) * 4096 + lane * 8; const bf16_t* vb = VF + (cgh * 16 + dvs * 2 + dd) * 4096 + lane * 8;
#pragma unroll
        for (int ks = 0; ks < 8; ++ks) {
            float f[8]; unpack8(vt[ks], f);
#pragma unroll
            for (int e = 0; e < 8; ++e) f[e] *= dec[ks][e];
            const bf16x8 bv = __builtin_bit_cast(bf16x8, pack8(f));
            Sacc[0] = MFMA32(a0[ks], bv, Sacc[0]); Sacc[1] = MFMA32(a1[ks], bv, Sacc[1]);
            if (c + 1 < 16) { a0[ks] = *(const bf16x8*)(ka + ks * 512); a1[ks] = *(const bf16x8*)(ka + 4 * 4096 + ks * 512); vt[ks] = *(const u32x4*)(vb + ks * 512); }
        }
    }
    float* sp = P.out + OUT_SP + (size_t)(b * 4 + h) * 256 * 512 + dvs * 64 + dd * 32 + r;
#pragma unroll
    for (int hf = 0; hf < 2; ++hf)
#pragma unroll
        for (int i = 0; i < 16; ++i) { const int dk = hf * 128 + dkt * 32 + (i & 3) + 8 * (i >> 2) + 4 * hh; sp[(size_t)dk * 512] = Sacc[hf][i]; }
}

DI void ro_loadb(int ks, const bf16_t* vp, const bf16_t* sp, bf16x8 (&dst)[2]) {
    if (ks < 8) { dst[0] = *(const bf16x8*)(vp + ks * 512); dst[1] = *(const bf16x8*)(vp + 4096 + ks * 512); }
    else { dst[0] = *(const bf16x8*)(sp + (ks - 8) * 512); dst[1] = *(const bf16x8*)(sp + 8192 + (ks - 8) * 512); }
}
template <int NKS>
DI void ro_mainloop(f32x16 (&acc)[4][2], bf16x8 (&bb)[4][2], const bf16_t* vp, const bf16_t* sp, ldsp lds, int r, int hh) {
#pragma unroll
    for (int ks = 0; ks < NKS; ++ks) {
        const bf16x8 b0 = bb[ks & 3][0], b1 = bb[ks & 3][1];
        if (ks + 4 < NKS) ro_loadb(ks + 4, vp, sp, bb[ks & 3]);
#pragma unroll
        for (int a = 0; a < 4; ++a) { if (ks >= 8 || ks < 2 * (a + 1)) { const bf16x8 af = *(const LAS bf16x8*)(lds + (a * 32 + r) * 784 + (ks * 16 + hh * 8) * 2);
            acc[a][0] = MFMA32(b0, af, acc[a][0]); acc[a][1] = MFMA32(b1, af, acc[a][1]); } }
    }
}

DI void retention_out(const Params& P, ldsp lds, int item, int wb) {
    const int tid = opaque_tid(wb), wid = tid >> 6, lane = tid & 63, r = lane & 31, hh = lane >> 5;
    const int pair = item >> 4, c = item & 15, b = pair >> 2, h = pair & 3;
    int tok0 = b * 2048 + c * 128; asm volatile("" : "+s"(tok0));
    constexpr int AIM = 0, RSB = 100352, RSTD = 104448, GAM = 104960, GIN = 105488;
    const bf16_t* Q = (const bf16_t*)(P.ws + OFF_Q); const bf16_t* KF = (const bf16_t*)(P.ws + OFF_K); const bf16_t* VF = (const bf16_t*)(P.ws + OFF_VT);
    const bf16_t* STG = (const bf16_t*)(P.ws + OFF_STG); const bf16_t* SG = (const bf16_t*)(P.ws + OFF_SG); bf16_t* RO = (bf16_t*)(P.ws + OFF_RO);
    LAS float* gam = (LAS float*)(lds + GAM); LAS float* gin = (LAS float*)(lds + GIN); LAS float* rsb = (LAS float*)(lds + RSB); LAS float* rstd = (LAS float*)(lds + RSTD);
    const int cg = tok0 >> 7;
    const int tt = wid >> 1, ss0 = (wid & 1) * 2;
    const bf16_t* kp = KF + ((size_t)(cg * 4 + h) * 4 + ss0) * 8192 + lane * 8;
    const bf16_t* vp = VF + ((size_t)(cg * 4 + h) * 16 + wid * 2) * 4096 + lane * 8;
    const bf16_t* sp = STG + (size_t)(pair * 16 + c) * 131072 + (size_t)wid * 2 * 8192 + lane * 8;
    u32x4 qv[8];
#pragma unroll
    for (int i = 0; i < 8; ++i) { const int it = tid + 512 * i, row = it >> 5, seg = it & 31; qv[i] = *(const u32x4*)(Q + (size_t)(tok0 + row) * 1024 + h * 256 + seg * 8); }
    bf16x8 kk[4][2], bb[4][2];
#pragma unroll
    for (int ks = 0; ks < 4; ++ks) { kk[ks][0] = *(const bf16x8*)(kp + ks * 512); kk[ks][1] = *(const bf16x8*)(kp + 8192 + ks * 512); }
#pragma unroll
    for (int ks = 0; ks < 4; ++ks) ro_loadb(ks, vp, sp, bb[ks]);
    __syncthreads();
    if (tid <= 128) { const double p = dpow_int(1.0 - __builtin_ldexp(1.0, -5 - h), tid); gam[tid] = (float)p; if (tid >= 1) gin[tid - 1] = (float)(1.0 / p); }
    __syncthreads();
#pragma unroll
    for (int i = 0; i < 8; ++i) { const int it = tid + 512 * i, row = it >> 5, seg = it & 31;
        float f[8]; unpack8(qv[i], f); const float gq = gam[row + 1];
#pragma unroll
        for (int e = 0; e < 8; ++e) f[e] *= gq;
        *(LAS u32x4*)(lds + AIM + row * 784 + (128 + seg * 8) * 2) = pack8(f); }
    __syncthreads();
    {
        f32x16 sacc[2];
#pragma unroll
        for (int i = 0; i < 16; ++i) { sacc[0][i] = 0.f; sacc[1][i] = 0.f; }
        if (ss0 <= tt) {
#pragma unroll
            for (int ks = 0; ks < 16; ++ks) {
                const bf16x8 a0 = kk[ks & 3][0], a1 = kk[ks & 3][1];
                if (ks + 4 < 16) { kk[ks & 3][0] = *(const bf16x8*)(kp + (ks + 4) * 512); kk[ks & 3][1] = *(const bf16x8*)(kp + 8192 + (ks + 4) * 512); }
                const bf16x8 bq = *(const LAS bf16x8*)(lds + AIM + (tt * 32 + r) * 784 + (128 + ks * 16 + hh * 8) * 2);
                sacc[0] = MFMA32(a0, bq, sacc[0]); sacc[1] = MFMA32(a1, bq, sacc[1]); }
        }
#pragma unroll
        for (int u = 0; u < 2; ++u)
#pragma unroll
            for (int g = 0; g < 4; ++g) { float pv[4]; const int t = tt * 32 + r;
#pragma unroll
                for (int e = 0; e < 4; ++e) { const int s = (ss0 + u) * 32 + 8 * g + 4 * hh + e; pv[e] = (t >= s) ? sacc[u][4 * g + e] * gin[s] : 0.f; }
                u32x2 pk; pk[0] = cvt_pk_bf16(pv[0], pv[1]); pk[1] = cvt_pk_bf16(pv[2], pv[3]);
                *(LAS u32x2*)(lds + AIM + t * 784 + ((ss0 + u) * 32 + 8 * g + 4 * hh) * 2) = pk; }
    }
    __syncthreads();
    f32x16 acc[4][2];
#pragma unroll
    for (int a = 0; a < 4; ++a)
#pragma unroll
        for (int d = 0; d < 2; ++d)
#pragma unroll
            for (int i = 0; i < 16; ++i) acc[a][d][i] = 0.f;
    if (c > 0) ro_mainloop<24>(acc, bb, vp, sp, lds, r, hh); else ro_mainloop<8>(acc, bb, vp, sp, lds, r, hh);
#pragma unroll
    for (int a = 0; a < 4; ++a) { float q = 0.f;
#pragma unroll
        for (int d = 0; d < 2; ++d)
#pragma unroll
            for (int i = 0; i < 16; ++i) q += acc[a][d][i] * acc[a][d][i];
        q += shx<32>(q);
        if (hh == 0) rsb[(a * 32 + r) * 8 + wid] = q; }
    __syncthreads();
    if (tid < 128) { float s = 0.f;
#pragma unroll
        for (int w = 0; w < 8; ++w) s += rsb[tid * 8 + w];
        rstd[tid] = rsqrtf(s * (1.f / 512.f) + EPSF); }
    __syncthreads();
#pragma unroll
    for (int th = 0; th < 2; ++th) {
#pragma unroll
        for (int ah = 0; ah < 2; ++ah) { const int a = th * 2 + ah; const float rs = rstd[a * 32 + r];
#pragma unroll
            for (int d = 0; d < 2; ++d)
#pragma unroll
                for (int g = 0; g < 4; ++g) { u32x2 pk; pk[0] = cvt_pk_bf16(acc[a][d][4 * g] * rs, acc[a][d][4 * g + 1] * rs); pk[1] = cvt_pk_bf16(acc[a][d][4 * g + 2] * rs, acc[a][d][4 * g + 3] * rs);
                    *(LAS u32x2*)(lds + AIM + (ah * 32 + r) * 1032 + (wid * 64 + d * 32 + 8 * g + 4 * hh) * 2) = pk; } }
        __syncthreads();
#pragma unroll
        for (int i = 0; i < 8; ++i) { const int it = tid + 512 * i, row = it >> 6, seg = it & 63; const size_t tok = (size_t)tok0 + th * 64 + row;
            const u32x2 lo = *(const LAS u32x2*)(lds + AIM + row * 1032 + seg * 16), hi = *(const LAS u32x2*)(lds + AIM + row * 1032 + seg * 16 + 8);
            float o[8], g[8]; unpack8((u32x4){lo[0], lo[1], hi[0], hi[1]}, o); unpack8(*(const u32x4*)(SG + tok * 2048 + h * 512 + seg * 8), g);
#pragma unroll
            for (int e = 0; e < 8; ++e) o[e] *= g[e];
            *(u32x4*)(RO + tok * 3072 + h * 512 + seg * 8) = pack8(o); }
        __syncthreads();
    }
}

DI void retention_sample(const Params& P, ldsp lds, int item, int wb) {
    const int tid = opaque_tid(wb), lane = tid & 63;
    const int bs = item >> 2, h = item & 3; const size_t tok = (size_t)NP + bs;
    const bf16_t* Q = (const bf16_t*)(P.ws + OFF_Q); const bf16_t* Kk = (const bf16_t*)(P.ws + OFF_K); const bf16_t* VT = (const bf16_t*)(P.ws + OFF_VT);
    const bf16_t* SG = (const bf16_t*)(P.ws + OFF_SG); bf16_t* RO = (bf16_t*)(P.ws + OFF_RO);
    LAS float* QF = (LAS float*)lds; LAS float* KF = QF + 256; LAS float* VF = QF + 512; LAS float* RED = QF + 1024;
    __syncthreads();
    if (tid < 256) { QF[tid] = bf2f(Q[tok * 1024 + h * 256 + tid]); KF[tid] = bf2f(Kk[kf_idx((int)tok, h, tid)]); }
    VF[tid] = bf2f(VT[vf_idx((int)tok, h, tid)]);
    __syncthreads();
    float qk = 0.f;
#pragma unroll
    for (int i = 0; i < 4; ++i) qk += QF[lane + 64 * i] * KF[lane + 64 * i];
    qk = sum_x63(qk);
    const float gamma = 1.f - __builtin_ldexpf(1.f, -5 - h);
    const int dv4 = (tid & 127) * 4, kg = tid >> 7;
    const size_t sb = ((size_t)(bs * 4 + h) * 256 + kg * 64) * 512 + dv4;
    const f32x4* S0 = (const f32x4*)(P.in[2] + sb); f32x4* S1 = (f32x4*)(P.out + OUT_SS + sb);
    const f32x4 v4 = *(const LAS f32x4*)(VF + dv4);
    f32x4 a4 = (f32x4){0.f, 0.f, 0.f, 0.f};
    for (int i0 = 0; i0 < 64; i0 += 32) {
        f32x4 s[32];
#pragma unroll
        for (int i = 0; i < 32; ++i) s[i] = __builtin_nontemporal_load(S0 + (size_t)(i0 + i) * 128);
#pragma unroll
        for (int i = 0; i < 32; ++i) { const float q = QF[kg * 64 + i0 + i], k = KF[kg * 64 + i0 + i];
            a4 += q * s[i];
            __builtin_nontemporal_store(gamma * s[i] + k * v4, S1 + (size_t)(i0 + i) * 128); }
    }
    *(LAS f32x4*)(RED + kg * 512 + dv4) = a4;
    __syncthreads();
    const float qs = RED[tid] + RED[512 + tid] + RED[1024 + tid] + RED[1536 + tid];
    const float o = qk * VF[tid] + gamma * qs;
    float q2 = o * o;
    q2 = sum_x63(q2);
    __syncthreads();
    if (lane == 0) RED[tid >> 6] = q2;
    __syncthreads();
    float tot = 0.f;
#pragma unroll
    for (int w = 0; w < 8; ++w) tot += RED[w];
    const float rs = rsqrtf(tot * (1.f / 512.f) + EPSF);
    RO[tok * 3072 + h * 512 + tid] = f2bf(bf2f(SG[tok * 2048 + h * 512 + tid]) * o * rs);
}

DI void gmlp_prompt(const Params& P, ldsp lds, int item, int wb) {
    const int tid = opaque_tid(wb), wid = tid >> 6, lane = tid & 63, r = lane & 31, hh = lane >> 5;
    const int b = item >> 6, c = (item >> 2) & 15, g = item & 3;
    int tok0 = b * 2048 + c * 128; asm volatile("" : "+s"(tok0));
    constexpr int WS_ = 0, GV = 34816, MU = 104448, RS = 104960;
    const bf16_t* GVT = (const bf16_t*)(P.ws + OFF_GVT); const bf16_t* GU = (const bf16_t*)(P.ws + OFF_GU); bf16_t* GI = (bf16_t*)(P.ws + OFF_RO);
    const float* st = (const float*)(P.ws + OFF_ST); const float* lnsum = st + (size_t)MP * 4; const float* lnsq = st + (size_t)MP * 5;
    LAS float* mu = (LAS float*)(lds + MU); LAS float* rs = (LAS float*)(lds + RS);
    float s1 = 0.f, s2 = 0.f;
    if (tid < 128) { s1 = lnsum[tok0 + tid]; s2 = lnsq[tok0 + tid]; }
    u32x4 xg[8];
#pragma unroll
    for (int i = 0; i < 8; ++i) { const int it = tid + 512 * i, row = it >> 4, seg = it & 15; xg[i] = *(const u32x4*)(GVT + (size_t)(g * 256 + row) * MP + tok0 + seg * 8); }
    f32x4 wv[4][2];
    { const float* W = P.in[8] + (size_t)g * 16384;
#pragma unroll
      for (int i = 0; i < 4; ++i) { const int it = tid + 512 * i, t = it >> 4, seg = it & 15; wv[i][0] = *(const f32x4*)(W + t * 128 + seg * 8); wv[i][1] = *(const f32x4*)(W + t * 128 + seg * 8 + 4); } }
    __syncthreads();
    if (tid < 128) { const float m = s1 * (1.f / 1024.f); const float var = fmaxf(s2 * (1.f / 1024.f) - m * m, 0.f); mu[tid] = m; rs[tid] = rsqrtf(var + EPSF); }
#pragma unroll
    for (int i = 0; i < 4; ++i) { const int it = tid + 512 * i, t = it >> 4, seg = it & 15;
        float v[8] = {wv[i][0][0], wv[i][0][1], wv[i][0][2], wv[i][0][3], wv[i][1][0], wv[i][1][1], wv[i][1][2], wv[i][1][3]};
#pragma unroll
        for (int e = 0; e < 8; ++e) v[e] = (seg * 8 + e <= t) ? v[e] : 0.f;
        *(LAS u32x4*)(lds + WS_ + t * 272 + seg * 16) = pack8(v); }
    __syncthreads();
    { const float* lg = P.in[6] + g * 256; const float* lb = P.in[7] + g * 256;
#pragma unroll
      for (int i = 0; i < 8; ++i) { const int it = tid + 512 * i, row = it >> 4, seg = it & 15;
          float v[8]; unpack8(xg[i], v); const float a = lg[row], bb = lb[row];
#pragma unroll
          for (int e = 0; e < 8; ++e) v[e] = (v[e] - mu[seg * 8 + e]) * rs[seg * 8 + e] * a + bb;
          *(LAS u32x4*)(lds + GV + row * 272 + seg * 16) = pack8(v); } }
    __syncthreads();
    const int tt = wid & 3, cb = (wid >> 2) * 4;
    f32x16 acc[4];
#pragma unroll
    for (int u = 0; u < 4; ++u)
#pragma unroll
        for (int i = 0; i < 16; ++i) acc[u][i] = 0.f;
    for (int ks = 0; ks < 2 * (tt + 1); ++ks) { const int ko = (ks * 16 + hh * 8) * 2;
        const bf16x8 a = *(const LAS bf16x8*)(lds + WS_ + (tt * 32 + r) * 272 + ko);
#pragma unroll
        for (int u = 0; u < 4; ++u) { const bf16x8 bv = *(const LAS bf16x8*)(lds + GV + ((cb + u) * 32 + r) * 272 + ko); acc[u] = MFMA32(bv, a, acc[u]); } }
    const int tl = tt * 32 + r; const size_t tok = (size_t)tok0 + tl; const float bi = P.in[9][g * 128 + tl];
#pragma unroll
    for (int u = 0; u < 4; ++u)
#pragma unroll
        for (int q = 0; q < 4; ++q) { const int ch = g * 256 + (cb + u) * 32 + 8 * q + 4 * hh;
            const u32x2 gu = *(const u32x2*)(GU + tok * 1024 + ch);
            u32x2 o; o[0] = cvt_pk_bf16(bf_lo(gu[0]) * (acc[u][4 * q] + bi), bf_hi(gu[0]) * (acc[u][4 * q + 1] + bi));
            o[1] = cvt_pk_bf16(bf_lo(gu[1]) * (acc[u][4 * q + 2] + bi), bf_hi(gu[1]) * (acc[u][4 * q + 3] + bi));
            *(u32x2*)(GI + tok * 3072 + 2048 + ch) = o; }
}
DI void gmlp_sample(const Params& P, int wb) {
    const bf16_t* GVT = (const bf16_t*)(P.ws + OFF_GVT); const bf16_t* GU = (const bf16_t*)(P.ws + OFF_GU); bf16_t* GI = (bf16_t*)(P.ws + OFF_RO);
    const float* st = (const float*)(P.ws + OFF_ST); const float* lnsum = st + (size_t)MP * 4; const float* lnsq = st + (size_t)MP * 5;
    for (size_t i = (size_t)blockIdx.x * 512 + opaque_tid(wb); i < (size_t)NSAMP * 1024; i += (size_t)gridDim.x * 512) {
        const int bs = (int)(i >> 10), ch = (int)(i & 1023), g = ch >> 8; const size_t tok = (size_t)NP + bs;
        const float m = lnsum[tok] * (1.f / 1024.f), var = fmaxf(lnsq[tok] * (1.f / 1024.f) - m * m, 0.f), rstd = rsqrtf(var + EPSF);
        const float x = bf2f(GVT[(size_t)ch * MP + tok]);
        const float gvn = (x - m) * rstd * P.in[6][ch] + P.in[7][ch];
        P.out[OUT_GV + i] = gvn;
        const float mixed = P.in[8][(size_t)g * 16384] * gvn + P.in[9][g * 128];
        GI[tok * 3072 + 2048 + ch] = f2bf(bf2f(GU[tok * 1024 + ch]) * mixed);
    }
}

DI void fixup_merge(const Params& P, int wb) {
    const bf16_t* AR = (const bf16_t*)(P.ws + OFF_AR); const bf16_t* AG = (const bf16_t*)(P.ws + OFF_AG); bf16_t* MM = (bf16_t*)(P.ws + OFF_MM);
    const float* ar = (const float*)(P.ws + OFF_ACC); const float* ag = ar + 8 * 131072;
    for (size_t i = (size_t)blockIdx.x * 512 + opaque_tid(wb); i < (size_t)NSAMP * 1024; i += (size_t)gridDim.x * 512) {
        const size_t gi = (size_t)NP * 1024 + i;
        float sr = 0.f, sg = 0.f;
#pragma unroll
        for (int k = 0; k < 8; ++k) sr += ar[(size_t)k * 131072 + i];
#pragma unroll
        for (int k = 0; k < 4; ++k) sg += ag[(size_t)k * 131072 + i];
        MM[gi] = f2bf(bf2f(AR[gi]) * sr + bf2f(AG[gi]) * sg); }
}
DI void fixup_o(const Params& P, int wb) {
    const int tid = opaque_tid(wb), lane = tid & 63, gw = blockIdx.x * 8 + (tid >> 6);
    if (gw >= NSAMP) return;
    const float* ao = (const float*)(P.ws + OFF_ACC) + 12 * 131072 + (size_t)gw * 1024 + lane * 16;
    const float* xr = P.in[1] + (size_t)gw * 1024 + lane * 16;
    float* H = (float*)(P.ws + OFF_H) + (size_t)(NP + gw) * 1024 + lane * 16; bf16_t* HB = (bf16_t*)(P.ws + OFF_HB) + (size_t)(NP + gw) * 1024 + lane * 16;
    float v[16], ss = 0.f;
#pragma unroll
    for (int i = 0; i < 4; ++i) { f32x4 a = *(const f32x4*)(ao + 4 * i); const f32x4 x = *(const f32x4*)(xr + 4 * i);
#pragma unroll
        for (int k = 1; k < 4; ++k) a += *(const f32x4*)(ao + (size_t)k * 131072 + 4 * i);
#pragma unroll
        for (int e = 0; e < 4; ++e) { v[4 * i + e] = a[e] + x[e]; ss += v[4 * i + e] * v[4 * i + e]; }
        *(f32x4*)(H + 4 * i) = (f32x4){v[4 * i], v[4 * i + 1], v[4 * i + 2], v[4 * i + 3]}; }
    *(u32x4*)HB = pack8(v); *(u32x4*)(HB + 8) = pack8(v + 8);
    ss = sum_x63(ss);
    if (lane == 0) ((float*)(P.ws + OFF_ST))[(size_t)MP * 6 + NP + gw] = ss;
}
DI void final_norm(const Params& P, int wb) {
    const float* ss2 = (const float*)(P.ws + OFF_ST) + (size_t)MP * 7; const float* g = P.in[15];
    const int tid = opaque_tid(wb);
    const bf16_t* Y2 = (const bf16_t*)(P.ws + OFF_T1);
    for (size_t i = (size_t)blockIdx.x * 512 + tid; i < (size_t)NP * 128; i += (size_t)gridDim.x * 512) {
        const int row = (int)(i >> 7), c8 = (int)(i & 127) * 8;
        const float rs = rsqrtf(ss2[row] * (1.f / 1024.f) + EPSF);
        float v[8]; unpack8(*(const u32x4*)(Y2 + (size_t)row * 1024 + c8), v);
        const f32x4 g0 = *(const f32x4*)(g + c8), g1 = *(const f32x4*)(g + c8 + 4);
        *(f32x4*)(P.out + OUT_Y + (size_t)row * 1024 + c8) = (f32x4){v[0] * rs * g0[0], v[1] * rs * g0[1], v[2] * rs * g0[2], v[3] * rs * g0[3]};
        *(f32x4*)(P.out + OUT_Y + (size_t)row * 1024 + c8 + 4) = (f32x4){v[4] * rs * g1[0], v[5] * rs * g1[1], v[6] * rs * g1[2], v[7] * rs * g1[3]};
    }
    const int lane = tid & 63, gw = blockIdx.x * 8 + (tid >> 6);
    if (gw < NSAMP) {
        const float* af = (const float*)(P.ws + OFF_ACC) + 16 * 131072 + (size_t)gw * 1024 + lane * 16;
        const float* H = (const float*)(P.ws + OFF_H) + (size_t)(NP + gw) * 1024 + lane * 16;
        float v[16], ss = 0.f;
#pragma unroll
        for (int i = 0; i < 4; ++i) { f32x4 a = *(const f32x4*)(af + 4 * i); const f32x4 x = *(const f32x4*)(H + 4 * i);
#pragma unroll
            for (int k = 1; k < 11; ++k) a += *(const f32x4*)(af + (size_t)k * 131072 + 4 * i);
#pragma unroll
            for (int e = 0; e < 4; ++e) { v[4 * i + e] = a[e] + x[e]; ss += v[4 * i + e] * v[4 * i + e]; } }
        ss = sum_x63(ss);
        const float rs = rsqrtf(ss * (1.f / 1024.f) + EPSF);
        float* y = P.out + OUT_Y + (size_t)(NP + gw) * 1024 + lane * 16;
#pragma unroll
        for (int i = 0; i < 4; ++i) { const f32x4 gg = *(const f32x4*)(g + lane * 16 + 4 * i);
            *(f32x4*)(y + 4 * i) = (f32x4){v[4 * i] * rs * gg[0], v[4 * i + 1] * rs * gg[1], v[4 * i + 2] * rs * gg[2], v[4 * i + 3] * rs * gg[3]}; }
    }
}

#define XB_TMO      128
#define XB_XCNT(j)  (256  + 64 * (j))
#define XB_XSUB(j)  (1280 + 64 * (j))
#define XB_XGEN(j)  (2304 + 64 * (j))
#define XB_TOP      3328
#define XB_TOPGEN   3392
#define XCD_BAR_WORDS 3456
#define XB_SPIN_CAP (1u << 22)
DI unsigned xb_ld(unsigned* p)              { return __hip_atomic_load(p, __ATOMIC_RELAXED, __HIP_MEMORY_SCOPE_AGENT); }
DI unsigned xb_add(unsigned* p, unsigned v) { return __hip_atomic_fetch_add(p, v, __ATOMIC_RELAXED, __HIP_MEMORY_SCOPE_AGENT); }
DI unsigned xb_xcc_id() { return (unsigned)__builtin_amdgcn_s_getreg((3 << 11) | 20) & 0xFu; }
#define XB_SPIN(cond, bar) do { unsigned _sp = 0; while (cond) { __builtin_amdgcn_s_sleep(1); \
    if ((++_sp & 255u) == 0u) { if (xb_ld(&(bar)[XB_TMO])) break; if (_sp > XB_SPIN_CAP) { atomicAdd(&(bar)[XB_TMO], 1u); break; } } } } while (0)
struct XcdBarrier { unsigned* bar; unsigned x; volatile LAS unsigned* st; };
DI XcdBarrier xcd_barrier_post(unsigned* bar, volatile LAS unsigned* st, int wb) {
    XcdBarrier b; b.bar = bar; b.x = xb_xcc_id(); b.st = st;
    if (opaque_tid(wb) == 0) (void)xb_add(&bar[XB_XCNT(b.x)], 1u);
    return b;
}
DI void xcd_barrier_complete(unsigned* bar, unsigned x, unsigned& nloc, unsigned& nx) {
    const unsigned G = gridDim.x * gridDim.y * gridDim.z;
    unsigned sum, cnt, mine, sp = 0u;
    for (;;) {
        sum = 0u; cnt = 0u; mine = 0u;
#pragma unroll
        for (unsigned j = 0; j < 16; ++j) { const unsigned c = xb_ld(&bar[XB_XCNT(j)]); sum += c; cnt += (c > 0u) ? 1u : 0u; mine = (j == x) ? c : mine; }
        if (sum == G) break;
        __builtin_amdgcn_s_sleep(1);
        if ((++sp & 255u) == 0u) { if (xb_ld(&bar[XB_TMO])) break; if (sp > XB_SPIN_CAP) { atomicAdd(&bar[XB_TMO], 1u); break; } }
    }
    nloc = mine > 0u ? mine : 1u; nx = cnt > 0u ? cnt : 1u;
}
DI void xcd_barrier(const XcdBarrier& b, int wb) {
    asm volatile("s_waitcnt vmcnt(0)" ::: "memory");
    __syncthreads();
    if (opaque_tid(wb) == 0) {
        unsigned* bar = b.bar;
        __builtin_amdgcn_s_waitcnt(0);
        unsigned nloc = b.st[0], nx = b.st[1];
        if (nloc == 0u) { xcd_barrier_complete(bar, b.x, nloc, nx); b.st[0] = nloc; b.st[1] = nx; }
        const unsigned old = xb_add(&bar[XB_XSUB(b.x)], 1u);
        const unsigned gen = old / nloc;
        if (old + 1u == (gen + 1u) * nloc) {
            __builtin_amdgcn_fence(__ATOMIC_RELEASE, "agent");
            asm volatile("s_waitcnt vmcnt(0)" ::: "memory");
            const unsigned og = xb_add(&bar[XB_TOP], 1u);
            const unsigned tg = og / nx;
            if (og + 1u == (tg + 1u) * nx) xb_add(&bar[XB_TOPGEN], 1u);
            else XB_SPIN(xb_ld(&bar[XB_TOPGEN]) == tg, bar);
            __builtin_amdgcn_fence(__ATOMIC_ACQUIRE, "agent");
            xb_add(&bar[XB_XGEN(b.x)], 1u);
            asm volatile("s_waitcnt vmcnt(0)" ::: "memory");
        } else {
            XB_SPIN(xb_ld(&bar[XB_XGEN(b.x)]) == gen, bar);
            __builtin_amdgcn_fence(__ATOMIC_ACQUIRE, "agent");
            asm volatile("s_waitcnt vmcnt(0)" ::: "memory");
        }
    }
    __syncthreads();
}

__global__ void __launch_bounds__(512, 2) fwd_megakernel(Params P) {
    extern __shared__ __attribute__((aligned(16))) unsigned char shm[];
    ldsp lds = (ldsp)shm;
    cg::grid_group grid = cg::this_grid();
    const int G = gridDim.x, c = blockIdx.x;
    unsigned char* ws = P.ws;
#define RELAUNDER() asm volatile("" : "+s"(ws))
    float* st = (float*)(ws + OFF_ST);
    float* sso = st; float* lnsum = st + (size_t)MP * 4; float* lnsq = st + (size_t)MP * 5; float* ssh = st + (size_t)MP * 6; float* ssh2 = st + (size_t)MP * 7;
    const float* rope = (const float*)(ws + OFF_ROPE);
    const int wb = __builtin_amdgcn_readfirstlane((int)threadIdx.x);
    volatile LAS unsigned* bst = (volatile LAS unsigned*)(lds + LDS_BYTES - 16);
    { const int t = opaque_tid(wb); if (t < 2) bst[t] = 0u; }
    __syncthreads();
    const XcdBarrier xb = xcd_barrier_post((unsigned*)(ws + OFF_BAR), bst, wb);
#ifndef PROBE_MASK
#define PROBE_MASK 0
#endif
#ifndef PROBE_K
#define PROBE_K 4
#endif
    unsigned long long tp_acc = 0ull, tp0 = 0ull;
#define PH_BEGIN(k) do { if (PROBE_MASK & (1 << (k))) tp0 = __builtin_amdgcn_s_memrealtime(); } while (0)
#define PH_END(k) do { if (PROBE_MASK & (1 << (k))) tp_acc += __builtin_amdgcn_s_memrealtime() - tp0; } while (0)

    PH_BEGIN(0);
    phase0(P, lds, wb);
    if (P.ws == nullptr) grid.sync();
    xcd_barrier(xb, wb);
    PH_END(0); PH_BEGIN(1);
    {
        pg8::Gemm g1{(const bf16_t*)(ws + OFF_XN), (const bf16_t*)(ws + OFF_WT1), MP, 6144, 1024, 1024, 1024};
        pg8::Order s1; s1.init(MP, 6144, G, c);
        EpiIn1 e1{ws, rope};
        pg8::gemm_phase(lds, g1, s1, e1, wb);
        pg8::Gemm g2{(const bf16_t*)(ws + OFF_WT2), (const bf16_t*)(ws + OFF_XN), 4096, MP, 1024, 1024, 1024};
        pg8::Order s2; s2.init(4096, MP, G, (c + G - (s1.nwg % G)) % G);
        EpiIn2 e2{(bf16_t*)(ws + OFF_KT), (bf16_t*)(ws + OFF_VT), (bf16_t*)(ws + OFF_GVT), (bf16_t*)(ws + OFF_K), rope, lnsum, lnsq};
        pg8::gemm_phase(lds, g2, s2, e2, wb);
        const int n1 = s1.nwg % G, n2 = s2.nwg % G;
        if (n1 + n2 < G) { if (c >= n1 + n2) wjobs(P, lds, opaque_tid(wb), 640 + (c - n1 - n2), G - n1 - n2, 1424); }
        else wjobs(P, lds, opaque_tid(wb), 640 + c, G, 1424);
    }
    xcd_barrier(xb, wb);
    PH_END(1); PH_BEGIN(2);
    if (G == 256) {
        if (c < 128) { retention_scan(P, lds, c, wb); retention_scan(P, lds, c + 128, wb); }
        else { for (int item = c - 128; item < 512; item += 128) retention_sample(P, lds, item, wb); }
    } else {
        for (int item = c; item < 512; item += G) retention_sample(P, lds, item, wb);
        for (int item = c; item < 256; item += G) retention_scan(P, lds, item, wb);
    }
    {
        unsigned* q = (unsigned*)(ws + OFF_BAR) + XCD_BAR_WORDS + 16;
        LAS unsigned* tk = (LAS unsigned*)(lds + LDS_BYTES - 32);
        for (;;) {
            __syncthreads();
            if (opaque_tid(wb) == 0) tk[0] = __hip_atomic_fetch_add(q, 1u, __ATOMIC_RELAXED, __HIP_MEMORY_SCOPE_AGENT);
            __syncthreads();
            const int item = (int)tk[0];
            if (item >= 512) break;
            gmlp_prompt(P, lds, item, wb);
        }
    }
    gmlp_sample(P, wb);
    xcd_barrier(xb, wb);
    PH_END(2); PH_BEGIN(11);
    for (int item = c; item < 512; item += G) retention_out(P, lds, item, wb);
    {
        pg8::SplitOrder sr; sr.init(64, 12, G, c);
        pg8::Gemm g3{(const bf16_t*)(ws + OFF_RO), (const bf16_t*)(ws + OFF_WRET), MP, 1024, 256, 3072, 3072};
        EpiSplit e3{(float*)(ws + OFF_ACC)};
        pg8::gemm_phase(lds, g3, sr, e3, wb);
    }
    xcd_barrier(xb, wb);
    PH_END(11); PH_BEGIN(3);
    fixup_merge(P, wb);
    {
        pg8::Order s; s.init(NP, 1024, G, c);
        pg8::Gemm g1{(const bf16_t*)(ws + OFF_RO), (const bf16_t*)(ws + OFF_WRET), NP, 1024, 3072, 3072, 3072};
        EpiMerge e1{(const bf16_t*)(ws + OFF_AR), (const bf16_t*)(ws + OFF_AG), (bf16_t*)(ws + OFF_MM)};
        pg8::gemm_phase(lds, g1, s, e1, wb);
    }
    xcd_barrier(xb, wb);
    PH_END(3); PH_BEGIN(4);
    {
        pg8::Order s; s.init(NP, 1024, G, c);
        pg8::Gemm g{(const bf16_t*)(ws + OFF_MM), (const bf16_t*)(ws + OFF_WO), NP, 1024, 1024, 1024, 1024};
        EpiO e{P.in[0], P.in[1], (float*)(ws + OFF_H), (bf16_t*)(ws + OFF_HB), ssh};
        pg8::gemm_phase(lds, g, s, e, wb);
        pg8::SplitOrder so; so.init(64, 4, G, c);
        pg8::Gemm g2{(const bf16_t*)(ws + OFF_MM), (const bf16_t*)(ws + OFF_WO), MP, 1024, 256, 1024, 1024};
        EpiSplit e2{(float*)(ws + OFF_ACC) + 12 * 131072};
        pg8::gemm_phase(lds, g2, so, e2, wb);
    }
    xcd_barrier(xb, wb);
    fixup_o(P, wb);
    xcd_barrier(xb, wb);
    PH_END(4); PH_BEGIN(5);
    {
        pg8::Order s; s.init(MP, 5632, G, c);
        pg8::Gemm g{(const bf16_t*)(ws + OFF_HB), (const bf16_t*)(ws + OFF_WF1), MP, 5632, 1024, 1024, 1024};
        EpiF1 e{ssh, (bf16_t*)(ws + OFF_ACT)};
        pg8::gemm_phase(lds, g, s, e, wb);
    }
    xcd_barrier(xb, wb);
    PH_END(5); PH_BEGIN(6);
    {
        pg8::Order s; s.init(NP, 1024, G, c);
        pg8::Gemm g{(const bf16_t*)(ws + OFF_ACT), (const bf16_t*)(ws + OFF_WF2), NP, 1024, 2816, 2816, 2816};
        EpiF2 e{(const bf16_t*)(ws + OFF_HB), (bf16_t*)(ws + OFF_T1), ssh2};
        pg8::gemm_phase(lds, g, s, e, wb);
        pg8::SplitOrder sf; sf.init(64, 11, G, c);
        pg8::Gemm g2{(const bf16_t*)(ws + OFF_ACT), (const bf16_t*)(ws + OFF_WF2), MP, 1024, 256, 2816, 2816};
        EpiSplit e2{(float*)(ws + OFF_ACC) + 16 * 131072};
        pg8::gemm_phase(lds, g2, sf, e2, wb);
    }
    xcd_barrier(xb, wb);
    PH_END(6); PH_BEGIN(7);
    final_norm(P, wb);
    PH_END(7);
    if (PROBE_MASK != 0 && blockIdx.x == 0) {
        __syncthreads();
        const unsigned long long t_end = __builtin_amdgcn_s_memrealtime() + (unsigned long long)PROBE_K * tp_acc;
        while (__builtin_amdgcn_s_memrealtime() < t_end) __builtin_amdgcn_s_sleep(8);
    }
}

extern "C" void kernel_launch(void* const* d_in, const int* in_sizes, int n_in, void* d_out, int out_size, void* d_ws, size_t ws_size, hipStream_t stream) {
    static int grid_blocks = 0;
    if (!grid_blocks) {
        int dev = 0, cus = 0, per_cu = 0;
        (void)hipGetDevice(&dev);
        (void)hipDeviceGetAttribute(&cus, hipDeviceAttributeMultiprocessorCount, dev);
        (void)hipFuncSetAttribute((const void*)fwd_megakernel, hipFuncAttributeMaxDynamicSharedMemorySize, LDS_BYTES);
        (void)hipOccupancyMaxActiveBlocksPerMultiprocessor(&per_cu, (const void*)fwd_megakernel, 512, LDS_BYTES);
        if (per_cu < 1) per_cu = 1;
        if (cus < 1) cus = 256;
        grid_blocks = cus * per_cu;
        if (ws_size < WS_END) fprintf(stderr, "kernel_launch: workspace too small: %zu < %zu\n", ws_size, (size_t)WS_END);
    }
    Params p{};
    for (int i = 0; i < 16; ++i) p.in[i] = (const float*)d_in[i];
    p.out = (float*)d_out; p.ws = (unsigned char*)d_ws;
    (void)hipMemsetAsync((unsigned char*)d_ws + OFF_BAR, 0, 16384, stream);
    void* args[] = {&p};
    hipError_t e = hipLaunchCooperativeKernel((const void*)fwd_megakernel, dim3(grid_blocks), dim3(512), args, LDS_BYTES, stream);
    if (e != hipSuccess) fprintf(stderr, "cooperative launch failed: %s (grid %d)\n", hipGetErrorString(e), grid_blocks);
}
```

```cpp
#include <hip/hip_runtime.h>
#include <hip/hip_cooperative_groups.h>
#include <cstdio>
namespace cg = cooperative_groups;

#define LAS __attribute__((address_space(3)))
#define DI __device__ __forceinline__
typedef unsigned short bf16_t;
typedef short bf16x8 __attribute__((ext_vector_type(8)));
typedef float f32x4 __attribute__((ext_vector_type(4)));
typedef float f32x2 __attribute__((ext_vector_type(2)));
typedef float f32x16 __attribute__((ext_vector_type(16)));
typedef unsigned u32x4 __attribute__((ext_vector_type(4)));
typedef unsigned u32x2 __attribute__((ext_vector_type(2)));
typedef LAS unsigned char* ldsp;

constexpr int NP = 16384, NSAMP = 128, MR = NP + NSAMP, MP = 16640;
constexpr int LDS_BYTES = 147456;
constexpr float EPSF = 1e-6f;

constexpr size_t SZ_MP1024_BF = (size_t)MP * 1024 * 2;
constexpr size_t OFF_XN = 0;
constexpr size_t OFF_WT1 = OFF_XN + SZ_MP1024_BF;
constexpr size_t OFF_WT2 = OFF_WT1 + (size_t)7168 * 1024 * 2;
constexpr size_t OFF_WRET = OFF_WT2 + (size_t)4096 * 1024 * 2;
constexpr size_t OFF_WGM = OFF_WRET + (size_t)1024 * 2048 * 2;
constexpr size_t OFF_WO = OFF_WGM + (size_t)1024 * 1024 * 2;
constexpr size_t OFF_WF1 = OFF_WO + (size_t)1024 * 1024 * 2;
constexpr size_t OFF_WF2 = OFF_WF1 + (size_t)5632 * 1024 * 2;
constexpr size_t OFF_Q = OFF_WF2 + (size_t)1024 * 2816 * 2;
constexpr size_t OFF_K = OFF_Q + SZ_MP1024_BF;
constexpr size_t OFF_SG = OFF_K + SZ_MP1024_BF;
constexpr size_t OFF_GU = OFF_SG + 2 * SZ_MP1024_BF;
constexpr size_t OFF_AR = OFF_GU + SZ_MP1024_BF;
constexpr size_t OFF_AG = OFF_AR + SZ_MP1024_BF;
constexpr size_t OFF_KT = OFF_AG + SZ_MP1024_BF;
constexpr size_t OFF_VT = OFF_KT + SZ_MP1024_BF;
constexpr size_t OFF_GVT = OFF_VT + 2 * SZ_MP1024_BF;
constexpr size_t OFF_RO = OFF_GVT + SZ_MP1024_BF;
constexpr size_t OFF_GI = OFF_RO + 2 * SZ_MP1024_BF;
constexpr size_t OFF_T1 = OFF_GI + SZ_MP1024_BF;
constexpr size_t OFF_MM = OFF_T1 + 2 * SZ_MP1024_BF;
constexpr size_t OFF_H = OFF_MM + SZ_MP1024_BF;
constexpr size_t OFF_HB = OFF_H + 2 * SZ_MP1024_BF;
constexpr size_t OFF_ACT = OFF_HB + SZ_MP1024_BF;
constexpr size_t OFF_ST = OFF_ACT + (size_t)MP * 2816 * 2;
constexpr size_t OFF_ROPE = OFF_ST + (size_t)MP * 8 * 4;
constexpr size_t OFF_BAR = OFF_ROPE + (size_t)2049 * 128 * 8;
constexpr size_t OFF_STG = OFF_BAR + 16384;
constexpr size_t OFF_ACC = OFF_STG + (size_t)32 * 16 * 512 * 256 * 2;
constexpr size_t WS_END = OFF_ACC + (size_t)27 * 128 * 1024 * 4;

constexpr size_t OUT_Y = 0;
constexpr size_t OUT_SP = (size_t)MR * 1024;
constexpr size_t OUT_SS = OUT_SP + (size_t)8 * 4 * 256 * 512;
constexpr size_t OUT_GV = OUT_SS + (size_t)128 * 4 * 256 * 512;

struct Params {
    const float* in[16];
    float* out;
    unsigned char* ws;
};

DI unsigned cvt_pk_bf16(float lo, float hi) { unsigned r; asm("v_cvt_pk_bf16_f32 %0, %1, %2" : "=v"(r) : "v"(lo), "v"(hi)); return r; }
DI float bf_lo(unsigned v) { return __uint_as_float(v << 16); }
DI float bf_hi(unsigned v) { return __uint_as_float(v & 0xffff0000u); }
DI float bf2f(bf16_t b) { return __uint_as_float(((unsigned)b) << 16); }
DI bf16_t f2bf(float f) { return (bf16_t)(cvt_pk_bf16(f, 0.f) & 0xffffu); }
DI u32x4 pack8(const float* v) { u32x4 p; p[0] = cvt_pk_bf16(v[0], v[1]); p[1] = cvt_pk_bf16(v[2], v[3]); p[2] = cvt_pk_bf16(v[4], v[5]); p[3] = cvt_pk_bf16(v[6], v[7]); return p; }
DI void unpack8(u32x4 p, float* v) { v[0] = bf_lo(p[0]); v[1] = bf_hi(p[0]); v[2] = bf_lo(p[1]); v[3] = bf_hi(p[1]); v[4] = bf_lo(p[2]); v[5] = bf_hi(p[2]); v[6] = bf_lo(p[3]); v[7] = bf_hi(p[3]); }
DI float fsigmoid(float x) { return __builtin_amdgcn_rcpf(1.f + __expf(-x)); }
DI float fsilu(float x) { return x * fsigmoid(x); }
DI float fgelu(float x) { const float u = 0.7978845608028654f * (x + 0.044715f * x * x * x); return x * fsigmoid(2.f * u); }
DI int opaque_tid(int wb) { int t = wb + (int)__builtin_amdgcn_mbcnt_hi(~0u, __builtin_amdgcn_mbcnt_lo(~0u, 0u)); asm volatile("" : "+v"(t)); return t; }
#define MFMA32(a, b, c) __builtin_amdgcn_mfma_f32_32x32x16_bf16((a), (b), (c), 0, 0, 0)

template <int M> DI float shx(float v) {
    if constexpr (M < 32) return __int_as_float(__builtin_amdgcn_ds_swizzle(__float_as_int(v), (M << 10) | 0x1f));
    else { int l = (int)__builtin_amdgcn_mbcnt_hi(~0u, __builtin_amdgcn_mbcnt_lo(~0u, 0u)); asm volatile("" : "+v"(l));
           return __int_as_float(__builtin_amdgcn_ds_bpermute((l ^ 32) << 2, __float_as_int(v))); }
}
DI float sum_x15(float v) { v += shx<1>(v); v += shx<2>(v); v += shx<4>(v); v += shx<8>(v); return v; }
DI float sum_x31(float v) { v = sum_x15(v); v += shx<16>(v); return v; }
DI float sum_x63(float v) { v = sum_x31(v); v += shx<32>(v); return v; }

DI size_t kf_idx(int tok, int h, int d) { const int cg = tok >> 7, s = tok & 127, d8 = d >> 3;
    return ((((((size_t)(cg * 4 + h) * 4 + (s >> 5)) * 16 + (d8 >> 1)) * 2 + (d8 & 1)) * 32 + (s & 31)) * 8) + (d & 7); }
DI size_t ktf_idx(int tok, int h, int dk) { const int cg = tok >> 7, s = tok & 127, s8 = s >> 3;
    return ((((((size_t)(cg * 4 + h) * 8 + (dk >> 5)) * 8 + (s8 >> 1)) * 2 + (s8 & 1)) * 32 + (dk & 31)) * 8) + (s & 7); }
DI size_t vf_idx(int tok, int h, int dv) { const int cg = tok >> 7, s = tok & 127, s8 = s >> 3;
    return ((((((size_t)(cg * 4 + h) * 16 + (dv >> 5)) * 8 + (s8 >> 1)) * 2 + (s8 & 1)) * 32 + (dv & 31)) * 8) + (s & 7); }

namespace pg8 {
constexpr int BM = 256, BK = 64, HALF = 128, HTB = HALF * BK * 2, STAGE_BYTES = 8 * HTB, NXCD = 8, WGM = 8;
DI int lds_byte(int r, int c) { const int st = (r >> 4) * 2 + (c >> 5), rr = r & 15, cc = c & 31, ob = rr * 64 + cc * 2; return st * 1024 + (ob ^ (((ob >> 9) & 1) << 5)); }
DI void stage_rc(int b, int& R, int& C) { const int st = b / 1024, sb = b % 1024, swz = sb ^ (((sb >> 9) & 1) << 5); R = (st >> 1) * 16 + swz / 64; C = (st & 1) * 32 + (swz % 64) / 2; }
DI int perm32(int rho) { const int n = rho >> 4, i = rho & 15; return 8 * (i >> 2) + 4 * n + (i & 3); }
struct Unit { int pm, pn, pk; };
struct Gemm { const bf16_t* A; const bf16_t* Bt; int M, N, K, lda, ldb; };
struct Order {
    int nM, nN, nwg, G, c;
    DI void init(int M, int N, int G_, int c_) { nM = M / BM; nN = N / BM; nwg = nM * nN; G = G_; c = c_; }
    DI bool next(int i, Unit& u) const {
        const long L = (long)i * G + c; if (L >= nwg) return false;
        int wgid = (int)L; { const int q = nwg / NXCD, r = nwg % NXCD, xcd = wgid % NXCD, off = wgid / NXCD; wgid = (xcd < r ? xcd * (q + 1) : r * (q + 1) + (xcd - r) * q) + off; }
        const int nig = WGM * nN, gid = wgid / nig, fm = gid * WGM, gsz = (nM - fm) < WGM ? (nM - fm) : WGM;
        u.pm = fm + ((wgid % nig) % gsz); u.pn = (wgid % nig) / gsz; u.pk = 0; return true;
    }
};
struct SplitOrder {
    int nunits, G, c, pm;
    DI void init(int pm_, int nsplit, int G_, int c_) { pm = pm_; nunits = 4 * nsplit; G = G_; c = c_; }
    DI bool next(int i, Unit& u) const { const int L = i * G + c; if (L >= nunits) return false; u.pm = pm; u.pn = L & 3; u.pk = L >> 2; return true; }
};

template <class Epi, class Sched>
DI void gemm_phase(ldsp lds, const Gemm g, const Sched& S, const Epi& E, int wb) {
    const int tid = opaque_tid(wb), wid = __builtin_amdgcn_readfirstlane(tid >> 6), lane = tid & 63, wr = wid >> 2, wc = wid & 3, fr = lane & 15, fq = lane >> 4;
    const int K = g.K, nt = K / BK;
    unsigned voffA[2], voffB[2];
#pragma unroll
    for (int i = 0; i < 2; ++i) { int R, C; stage_rc(tid * 16 + i * 8192, R, C); const int Rb = Epi::PERM ? ((R & ~31) + perm32(R & 31)) : R;
        voffA[i] = (unsigned)(R * g.lda + C) * 2u; voffB[i] = (unsigned)(Rb * g.ldb + C) * 2u; }
    const size_t kstep = (size_t)(BK * 2);
    const size_t hstepA = (size_t)HALF * g.lda * 2, hstepB = (size_t)HALF * g.ldb * 2;
    const size_t tstepA = 2 * hstepA, tstepB = 2 * hstepB, kslice = (size_t)K * 2;
    const unsigned ldsw = (unsigned)wid * 1024u;
    const int aoff = lds_byte(wr * 64 + fr, fq * 8), boff = lds_byte(wc * 32 + fr, fq * 8);
#define PG8_SA(b, h) (((b) * 2 + (h)) * HTB)
#define PG8_SB(b, h) ((4 + (b) * 2 + (h)) * HTB)
#define PG8_STAGE(bufoff, gbase, voff) do { _Pragma("unroll") for (int _i = 0; _i < 2; ++_i) \
        __builtin_amdgcn_global_load_lds((const unsigned*)((const char*)(gbase) + (voff)[_i]), (LAS unsigned*)(lds + (bufoff) + ldsw + _i * 8192), 16, 0, 0); } while (0)
#define PG8_LDA(dst, b, h) do { _Pragma("unroll") for (int m = 0; m < 4; ++m) _Pragma("unroll") for (int k = 0; k < 2; ++k) dst[m][k] = *(const LAS bf16x8*)(lds + PG8_SA(b, h) + aoff + m * 2048 + k * 1024); } while (0)
#define PG8_LDB(dst, b, h) do { _Pragma("unroll") for (int n = 0; n < 2; ++n) _Pragma("unroll") for (int k = 0; k < 2; ++k) dst[n][k] = *(const LAS bf16x8*)(lds + PG8_SB(b, h) + boff + n * 2048 + k * 1024); } while (0)
#define PG8_MMA(ai, bj, At, Bt) do { __builtin_amdgcn_s_setprio(1); _Pragma("unroll") for (int m = 0; m < 4; ++m) _Pragma("unroll") for (int n = 0; n < 2; ++n) _Pragma("unroll") for (int k = 0; k < 2; ++k) \
        acc[ai][bj][m][n] = __builtin_amdgcn_mfma_f32_16x16x32_bf16(Bt[n][k], At[m][k], acc[ai][bj][m][n], 0, 0, 0); __builtin_amdgcn_s_setprio(0); } while (0)
#define PG8_WAIT_V(n) asm volatile("s_waitcnt vmcnt(" #n ")" ::: "memory")
#define PG8_WAIT_L(n) asm volatile("s_waitcnt lgkmcnt(" #n ")" ::: "memory")
#define PG8_BAR __builtin_amdgcn_s_barrier()
#define PG8_SCHED __builtin_amdgcn_sched_barrier(0)
    Unit cur, nxt; int ui = 0;
    if (!S.next(0, cur)) return;
    f32x4 acc[2][2][4][2];
#pragma unroll
    for (int a = 0; a < 2; ++a)
#pragma unroll
        for (int b = 0; b < 2; ++b)
#pragma unroll
            for (int m = 0; m < 4; ++m)
#pragma unroll
                for (int n = 0; n < 2; ++n) acc[a][b][m][n] = (f32x4){0.f, 0.f, 0.f, 0.f};
    bf16x8 At[4][2], B0[2][2], B1[2][2];
    const char* cA = (const char*)g.A + (size_t)cur.pm * tstepA + (size_t)cur.pk * kslice; const char* cB = (const char*)g.Bt + (size_t)cur.pn * tstepB + (size_t)cur.pk * kslice;
    PG8_STAGE(PG8_SB(0, 0), cB, voffB); PG8_STAGE(PG8_SA(0, 0), cA, voffA); PG8_STAGE(PG8_SB(0, 1), cB + hstepB, voffB); PG8_STAGE(PG8_SA(0, 1), cA + hstepA, voffA);
    if (wr == 1) PG8_BAR;
    PG8_WAIT_V(4); PG8_BAR;
    PG8_STAGE(PG8_SB(1, 0), cB + kstep, voffB); PG8_STAGE(PG8_SA(1, 0), cA + kstep, voffA); PG8_STAGE(PG8_SB(1, 1), cB + hstepB + kstep, voffB);
    PG8_WAIT_V(6); PG8_BAR;
    for (;;) {
        const bool has_next = S.next(ui + 1, nxt);
        const char* nA = has_next ? (const char*)g.A + (size_t)nxt.pm * tstepA + (size_t)nxt.pk * kslice : cA; const char* nB = has_next ? (const char*)g.Bt + (size_t)nxt.pn * tstepB + (size_t)nxt.pk * kslice : cB;
        for (int t = 0; t < nt; t += 2) {
            const bool last = (t == nt - 2);
            const char* a1 = cA + (size_t)(t + 1) * kstep;
            const char* a2 = last ? nA : cA + (size_t)(t + 2) * kstep; const char* b2 = last ? nB : cB + (size_t)(t + 2) * kstep;
            const char* a3 = a2 + kstep; const char* b3 = b2 + kstep;
            PG8_LDB(B0, 0, 0); PG8_SCHED; PG8_LDA(At, 0, 0); PG8_STAGE(PG8_SA(1, 1), a1 + hstepA, voffA);
            PG8_WAIT_L(8); PG8_BAR; PG8_WAIT_L(0); PG8_MMA(0, 0, At, B0); PG8_BAR; PG8_SCHED;
            PG8_LDB(B1, 0, 1); PG8_STAGE(PG8_SB(0, 0), b2, voffB);
            PG8_BAR; PG8_WAIT_L(0); PG8_MMA(0, 1, At, B1); PG8_BAR;
            PG8_LDA(At, 0, 1); PG8_STAGE(PG8_SA(0, 0), a2, voffA);
            PG8_BAR; PG8_WAIT_L(0); PG8_MMA(1, 0, At, B0); PG8_BAR; PG8_SCHED;
            PG8_STAGE(PG8_SB(0, 1), b2 + hstepB, voffB);
            PG8_WAIT_V(6); PG8_BAR; PG8_MMA(1, 1, At, B1); PG8_BAR;
            PG8_LDB(B0, 1, 0); PG8_SCHED; PG8_LDA(At, 1, 0); PG8_STAGE(PG8_SA(0, 1), a2 + hstepA, voffA);
            PG8_WAIT_L(8); PG8_BAR; PG8_WAIT_L(0); PG8_MMA(0, 0, At, B0); PG8_BAR; PG8_SCHED;
            PG8_LDB(B1, 1, 1); PG8_STAGE(PG8_SB(1, 0), b3, voffB);
            PG8_BAR; PG8_WAIT_L(0); PG8_MMA(0, 1, At, B1); PG8_BAR;
            PG8_LDA(At, 1, 1); PG8_STAGE(PG8_SA(1, 0), a3, voffA);
            PG8_BAR; PG8_WAIT_L(0); PG8_MMA(1, 0, At, B0); PG8_BAR; PG8_SCHED;
            PG8_STAGE(PG8_SB(1, 1), b3 + hstepB, voffB);
            PG8_WAIT_V(6); PG8_BAR; PG8_MMA(1, 1, At, B1); PG8_BAR;
            if constexpr (Epi::KHOOK) { if (t + 2 == Epi::KHOOK_AT) { int fr2 = fr, fq2 = fq; asm volatile("" : "+v"(fr2), "+v"(fq2)); E.khook(acc, cur, t, wr, wc, fr2, fq2); } }
        }
        { int fr2 = fr, fq2 = fq; asm volatile("" : "+v"(fr2), "+v"(fq2));
          E(acc, cur, wr, wc, fr2, fq2); }
        if (!has_next) break;
#pragma unroll
        for (int a = 0; a < 2; ++a)
#pragma unroll
            for (int b = 0; b < 2; ++b)
#pragma unroll
                for (int m = 0; m < 4; ++m)
#pragma unroll
                    for (int n = 0; n < 2; ++n) acc[a][b][m][n] = (f32x4){0.f, 0.f, 0.f, 0.f};
        cur = nxt; cA = nA; cB = nB; ++ui;
    }
    PG8_WAIT_V(0);
    if (wr == 0) PG8_BAR;
    PG8_BAR;
#undef PG8_SA
#undef PG8_SB
#undef PG8_STAGE
#undef PG8_LDA
#undef PG8_LDB
#undef PG8_MMA
#undef PG8_WAIT_V
#undef PG8_WAIT_L
#undef PG8_BAR
#undef PG8_SCHED
}
}
using pg8::Unit;
typedef f32x4 Acc[2][2][4][2];
#define EPI_UNROLL _Pragma("unroll")
DI void acc8(const Acc& acc, int ai, int bj, int m, float* v) {
    v[0] = acc[ai][bj][m][0][0]; v[1] = acc[ai][bj][m][0][1]; v[2] = acc[ai][bj][m][0][2]; v[3] = acc[ai][bj][m][0][3];
    v[4] = acc[ai][bj][m][1][0]; v[5] = acc[ai][bj][m][1][1]; v[6] = acc[ai][bj][m][1][2]; v[7] = acc[ai][bj][m][1][3];
}

struct EpiIn1 {
    static constexpr bool PERM = true, KHOOK = false;
    unsigned char* ws; const float* rope;
    DI void operator()(const Acc& acc, const Unit& u, int wr, int wc, int fr, int fq) const {
        const int pn = u.pn, row0 = u.pm * 256 + wr * 64 + fr, cl = wc * 32 + 8 * fq;
        if (pn < 4) {
            bf16_t* dst = (bf16_t*)(ws + OFF_Q); const int cb = pn * 256;
            f32x4 cr[4], nr[4];
            { const int row = row0, pidx = row < NP ? (row & 2047) : 2048; const f32x4* rp = (const f32x4*)(rope + ((size_t)pidx * 128 + cl) * 2);
              EPI_UNROLL for (int q = 0; q < 4; ++q) cr[q] = rp[q]; }
            EPI_UNROLL for (int it = 0; it < 8; ++it) { const int ai = it >> 2, m = it & 3; const int row = row0 + ai * 128 + m * 16;
                if (it < 7) { const int nrow = row0 + ((it + 1) >> 2) * 128 + ((it + 1) & 3) * 16, pidx = nrow < NP ? (nrow & 2047) : 2048;
                    const f32x4* rp = (const f32x4*)(rope + ((size_t)pidx * 128 + cl) * 2);
                    EPI_UNROLL for (int q = 0; q < 4; ++q) nr[q] = rp[q]; }
                float x1[8], x2[8], o1[8], o2[8]; acc8(acc, ai, 0, m, x1); acc8(acc, ai, 1, m, x2);
                EPI_UNROLL for (int q = 0; q < 4; ++q) { const f32x4 cs = cr[q];
                    o1[2 * q] = x1[2 * q] * cs[0] - x2[2 * q] * cs[1]; o2[2 * q] = x1[2 * q] * cs[1] + x2[2 * q] * cs[0];
                    o1[2 * q + 1] = x1[2 * q + 1] * cs[2] - x2[2 * q + 1] * cs[3]; o2[2 * q + 1] = x1[2 * q + 1] * cs[3] + x2[2 * q + 1] * cs[2]; }
                bf16_t* rowp = dst + (size_t)row * 1024 + cb + cl; *(u32x4*)rowp = pack8(o1); *(u32x4*)(rowp + 128) = pack8(o2);
                EPI_UNROLL for (int q = 0; q < 4; ++q) cr[q] = nr[q];
                __builtin_amdgcn_sched_barrier(0);
            }
        } else {
            size_t doff; int ld, cb, mode;
            if (pn < 12) { doff = OFF_SG; ld = 2048; cb = (pn - 4) * 256; mode = 0; }
            else if (pn < 16) { doff = OFF_GU; ld = 1024; cb = (pn - 12) * 256; mode = 1; }
            else if (pn < 20) { doff = OFF_AR; ld = 1024; cb = (pn - 16) * 256; mode = 2; }
            else { doff = OFF_AG; ld = 1024; cb = (pn - 20) * 256; mode = 2; }
            bf16_t* dst = (bf16_t*)(ws + doff);
            EPI_UNROLL for (int ai = 0; ai < 2; ++ai) EPI_UNROLL for (int m = 0; m < 4; ++m) {
                const int row = row0 + ai * 128 + m * 16;
                EPI_UNROLL for (int bj = 0; bj < 2; ++bj) { float v[8]; acc8(acc, ai, bj, m, v);
                    if (mode == 0) { EPI_UNROLL for (int e = 0; e < 8; ++e) v[e] = fsilu(v[e]); }
                    else if (mode == 1) { EPI_UNROLL for (int e = 0; e < 8; ++e) v[e] = fgelu(v[e]); }
                    else { EPI_UNROLL for (int e = 0; e < 8; ++e) v[e] = fsigmoid(v[e]); }
                    *(u32x4*)(dst + (size_t)row * ld + cb + bj * 128 + cl) = pack8(v); }
            }
        }
    }
};
struct EpiIn2 {
    static constexpr bool PERM = true, KHOOK = false;
    bf16_t *KT, *VT, *GVT, *KF; const float* rope; float *lnsum, *lnsq;
    DI void operator()(const Acc& acc, const Unit& u, int wr, int wc, int fr, int fq) const {
        const int pm = u.pm, tl = wc * 32 + 8 * fq;
        if (pm < 4) {
            f32x2 cs[8], ns[8];
            { const int tok = u.pn * 256 + tl, j = wr * 64 + fr; const int pbase = tok < NP ? (tok & 2047) : 2048, pinc = tok < NP ? 1 : 0;
              EPI_UNROLL for (int e = 0; e < 8; ++e) cs[e] = *(const f32x2*)(rope + ((size_t)(pbase + pinc * e) * 128 + j) * 2); }
            EPI_UNROLL for (int it = 0; it < 8; ++it) { const int m = it >> 1, bj = it & 1; const int j = wr * 64 + m * 16 + fr; const int tok = u.pn * 256 + bj * 128 + tl;
                if (it < 7) { const int nm = (it + 1) >> 1, nb = (it + 1) & 1; const int nj = wr * 64 + nm * 16 + fr, ntok = u.pn * 256 + nb * 128 + tl;
                    const int pbase = ntok < NP ? (ntok & 2047) : 2048, pinc = ntok < NP ? 1 : 0;
                    EPI_UNROLL for (int e = 0; e < 8; ++e) ns[e] = *(const f32x2*)(rope + ((size_t)(pbase + pinc * e) * 128 + nj) * 2); }
                EPI_UNROLL for (int hf = 0; hf < 2; ++hf) {
                    float x1[8], x2[8], o[8]; acc8(acc, 0, bj, m, x1); acc8(acc, 1, bj, m, x2);
                    EPI_UNROLL for (int e = 0; e < 8; ++e) o[e] = (hf == 0 ? (x1[e] * cs[e][0] - x2[e] * cs[e][1]) : (x1[e] * cs[e][1] + x2[e] * cs[e][0])) * 0.0625f;
                    *(u32x4*)(KT + ktf_idx(tok, pm, hf * 128 + j)) = pack8(o);
#define TR_STAGE(KK) { const bool up = (fr & KK) != 0; EPI_UNROLL for (int e = 0; e < 8; ++e) { if ((e & KK) == 0) { \
                        const float a = o[e], b = o[e ^ KK]; const float rcv = shx<KK>(up ? a : b); o[e] = up ? rcv : a; o[e ^ KK] = up ? b : rcv; } } }
                    TR_STAGE(4) TR_STAGE(2) TR_STAGE(1)
#undef TR_STAGE
                    *(u32x4*)(KF + kf_idx(tok + (fr & 7), pm, hf * 128 + wr * 64 + m * 16 + (fr & 8))) = pack8(o); }
                EPI_UNROLL for (int e = 0; e < 8; ++e) cs[e] = ns[e];
                __builtin_amdgcn_sched_barrier(0); }
        } else if (pm < 12) {
            EPI_UNROLL for (int ai = 0; ai < 2; ++ai) EPI_UNROLL for (int m = 0; m < 4; ++m) { const int r = (pm - 4) * 256 + ai * 128 + wr * 64 + m * 16 + fr;
                EPI_UNROLL for (int bj = 0; bj < 2; ++bj) { float v[8]; acc8(acc, ai, bj, m, v);
                    *(u32x4*)(VT + vf_idx(u.pn * 256 + bj * 128 + tl, r >> 9, r & 511)) = pack8(v); } }
        } else {
            EPI_UNROLL for (int bj = 0; bj < 2; ++bj) {
                float s1[8], s2[8];
                EPI_UNROLL for (int e = 0; e < 8; ++e) { s1[e] = 0.f; s2[e] = 0.f; }
                EPI_UNROLL for (int ai = 0; ai < 2; ++ai) EPI_UNROLL for (int m = 0; m < 4; ++m) { const int r = (pm - 12) * 256 + ai * 128 + wr * 64 + m * 16 + fr;
                    float v[8]; acc8(acc, ai, bj, m, v);
                    EPI_UNROLL for (int e = 0; e < 8; ++e) { v[e] = fgelu(v[e]); s1[e] += v[e]; s2[e] += v[e] * v[e]; }
                    *(u32x4*)(GVT + (size_t)r * MP + u.pn * 256 + bj * 128 + tl) = pack8(v); __builtin_amdgcn_sched_barrier(0); }
                EPI_UNROLL for (int e = 0; e < 8; ++e) {
                    float a = s1[e], b = s2[e];
                    a = sum_x15(a); b = sum_x15(b);
                    if (fr == 0) { const int tok = u.pn * 256 + bj * 128 + tl + e; unsafeAtomicAdd(lnsum + tok, a); unsafeAtomicAdd(lnsq + tok, b); } }
                __builtin_amdgcn_sched_barrier(0);
            }
        }
    }
};
struct EpiMerge {
    static constexpr bool PERM = true, KHOOK = true; static constexpr int KHOOK_AT = 32;
    const bf16_t* AR; const bf16_t* AG; bf16_t* MM;
    DI void khook(Acc& acc, const Unit& u, int t, int wr, int wc, int fr, int fq) const {
        const size_t base = (size_t)(u.pm * 256 + wr * 64 + fr) * 1024 + u.pn * 256 + wc * 32 + 8 * fq;
        EPI_UNROLL for (int it = 0; it < 8; ++it) { const int ai = it >> 2, m = it & 3; const size_t off = base + (size_t)(ai * 128 + m * 16) * 1024;
            EPI_UNROLL for (int bj = 0; bj < 2; ++bj) { float a[8], g[8]; unpack8(*(const u32x4*)(AR + off + bj * 128), a); unpack8(*(const u32x4*)(AG + off + bj * 128), g);
                EPI_UNROLL for (int e = 0; e < 4; ++e) { acc[ai][bj][m][0][e] *= a[e] * __builtin_amdgcn_rcpf(fmaxf(g[e], 1e-20f)); acc[ai][bj][m][1][e] *= a[4 + e] * __builtin_amdgcn_rcpf(fmaxf(g[4 + e], 1e-20f)); } }
            __builtin_amdgcn_sched_barrier(0); }
    }
    DI void operator()(const Acc& acc, const Unit& u, int wr, int wc, int fr, int fq) const {
        const size_t base = (size_t)(u.pm * 256 + wr * 64 + fr) * 1024 + u.pn * 256 + wc * 32 + 8 * fq;
        u32x4 cg[2], ng[2];
        cg[0] = *(const u32x4*)(AG + base); cg[1] = *(const u32x4*)(AG + base + 128);
        EPI_UNROLL for (int it = 0; it < 8; ++it) { const int ai = it >> 2, m = it & 3; const size_t off = base + (size_t)(ai * 128 + m * 16) * 1024;
            if (it < 7) { const size_t no = base + (size_t)(((it + 1) >> 2) * 128 + ((it + 1) & 3) * 16) * 1024; ng[0] = *(const u32x4*)(AG + no); ng[1] = *(const u32x4*)(AG + no + 128); }
            EPI_UNROLL for (int bj = 0; bj < 2; ++bj) { float v[8], g[8]; acc8(acc, ai, bj, m, v); unpack8(cg[bj], g);
                EPI_UNROLL for (int e = 0; e < 8; ++e) v[e] *= fmaxf(g[e], 1e-20f);
                *(u32x4*)(MM + off + bj * 128) = pack8(v); }
            cg[0] = ng[0]; cg[1] = ng[1]; __builtin_amdgcn_sched_barrier(0); }
    }
};
struct EpiO {
    static constexpr bool PERM = true, KHOOK = false;
    const float *xp, *xs; float* H; bf16_t* HB; float* ssh;
    DI void operator()(const Acc& acc, const Unit& u, int wr, int wc, int fr, int fq) const {
        const int row0 = u.pm * 256 + wr * 64 + fr;
        const size_t base = (size_t)row0 * 1024 + u.pn * 256 + wc * 32 + 8 * fq;
        f32x4 cx[4], nx[4];
        EPI_UNROLL for (int bj = 0; bj < 2; ++bj) { cx[2 * bj] = *(const f32x4*)(xp + base + bj * 128); cx[2 * bj + 1] = *(const f32x4*)(xp + base + bj * 128 + 4); }
        EPI_UNROLL for (int it = 0; it < 8; ++it) { const int ai = it >> 2, m = it & 3; const size_t off = base + (size_t)(ai * 128 + m * 16) * 1024;
            if (it < 7) { const size_t no = base + (size_t)(((it + 1) >> 2) * 128 + ((it + 1) & 3) * 16) * 1024;
                EPI_UNROLL for (int bj = 0; bj < 2; ++bj) { nx[2 * bj] = *(const f32x4*)(xp + no + bj * 128); nx[2 * bj + 1] = *(const f32x4*)(xp + no + bj * 128 + 4); } }
            float ss = 0.f;
            EPI_UNROLL for (int bj = 0; bj < 2; ++bj) { float v[8]; acc8(acc, ai, bj, m, v);
                EPI_UNROLL for (int e = 0; e < 4; ++e) { v[e] += cx[2 * bj][e]; v[4 + e] += cx[2 * bj + 1][e]; }
                EPI_UNROLL for (int e = 0; e < 8; ++e) ss += v[e] * v[e];
                *(u32x4*)(HB + off + bj * 128) = pack8(v); }
            ss += shx<16>(ss); ss += shx<32>(ss);
            if (fq == 0) unsafeAtomicAdd(ssh + row0 + ai * 128 + m * 16, ss);
            EPI_UNROLL for (int q = 0; q < 4; ++q) cx[q] = nx[q];
            __builtin_amdgcn_sched_barrier(0); }
    }
};
struct EpiF1 {
    static constexpr bool PERM = true, KHOOK = false;
    const float* ssh; bf16_t* ACT;
    DI void operator()(const Acc& acc, const Unit& u, int wr, int wc, int fr, int fq) const {
        EPI_UNROLL for (int ai = 0; ai < 2; ++ai) EPI_UNROLL for (int m = 0; m < 4; ++m) { const int row = u.pm * 256 + ai * 128 + wr * 64 + m * 16 + fr;
            const float rs = rsqrtf(ssh[row] * (1.f / 1024.f) + EPSF);
            float g[8], p[8]; acc8(acc, ai, 0, m, g); acc8(acc, ai, 1, m, p);
            EPI_UNROLL for (int e = 0; e < 8; ++e) g[e] = fsilu(g[e] * rs) * (p[e] * rs);
            *(u32x4*)(ACT + (size_t)row * 2816 + u.pn * 128 + wc * 32 + 8 * fq) = pack8(g); }
    }
};
struct EpiF2 {
    static constexpr bool PERM = true, KHOOK = false;
    const bf16_t* HB; bf16_t* Y2; float* ssh2;
    DI void operator()(const Acc& acc, const Unit& u, int wr, int wc, int fr, int fq) const {
        const int row0 = u.pm * 256 + wr * 64 + fr;
        const size_t base = (size_t)row0 * 1024 + u.pn * 256 + wc * 32 + 8 * fq;
        u32x4 cx[2], nx[2];
        cx[0] = *(const u32x4*)(HB + base); cx[1] = *(const u32x4*)(HB + base + 128);
        EPI_UNROLL for (int it = 0; it < 8; ++it) { const int ai = it >> 2, m = it & 3; const size_t off = base + (size_t)(ai * 128 + m * 16) * 1024;
            if (it < 7) { const size_t no = base + (size_t)(((it + 1) >> 2) * 128 + ((it + 1) & 3) * 16) * 1024; nx[0] = *(const u32x4*)(HB + no); nx[1] = *(const u32x4*)(HB + no + 128); }
            float ss = 0.f;
            EPI_UNROLL for (int bj = 0; bj < 2; ++bj) { float v[8], h[8]; acc8(acc, ai, bj, m, v); unpack8(cx[bj], h);
                EPI_UNROLL for (int e = 0; e < 8; ++e) { v[e] += h[e]; ss += v[e] * v[e]; }
                *(u32x4*)(Y2 + off + bj * 128) = pack8(v); }
            ss += shx<16>(ss); ss += shx<32>(ss);
            if (fq == 0) unsafeAtomicAdd(ssh2 + row0 + ai * 128 + m * 16, ss);
            cx[0] = nx[0]; cx[1] = nx[1];
            __builtin_amdgcn_sched_barrier(0); }
    }
};
struct EpiSplit {
    static constexpr bool PERM = true, KHOOK = false;
    float* SLAB;
    DI void operator()(const Acc& acc, const Unit& u, int wr, int wc, int fr, int fq) const {
        float* sl = SLAB + (size_t)u.pk * 131072;
        EPI_UNROLL for (int m = 0; m < 4; ++m) { const int row = wr * 64 + m * 16 + fr;
            EPI_UNROLL for (int bj = 0; bj < 2; ++bj) { const int col = u.pn * 256 + bj * 128 + wc * 32 + 8 * fq;
                *(f32x4*)(sl + (size_t)row * 1024 + col) = acc[0][bj][m][0]; *(f32x4*)(sl + (size_t)row * 1024 + col + 4) = acc[0][bj][m][1]; } }
    }
};

DI double dpow_int(double base, int n) { double r = 1.0; for (int b = 0; b < 8; ++b) { if ((n >> b) & 1) r *= base; base *= base; } return r; }

struct WJob { const float* src; const float* ksc; bf16_t* d0; bf16_t* d1; int N, k0, n0, ldk, hi0; long r0, r1; };
DI WJob wjob_decode(const Params& P, int job) {
    WJob w; w.ksc = nullptr; w.d0 = nullptr; w.d1 = nullptr; w.hi0 = 128; w.r0 = 0; w.r1 = 0;
    int kt, ntile; unsigned char* ws = P.ws;
    if (job < 640) { w.src = P.in[4]; w.N = 10240; kt = job / 40; ntile = job % 40; w.ldk = 1024;
        const int n0 = ntile * 256, sec = n0 >> 10;
        bf16_t* W1 = (bf16_t*)(ws + OFF_WT1); bf16_t* W2 = (bf16_t*)(ws + OFF_WT2);
        if (sec == 0) { w.d0 = W1; w.r0 = n0; }
        else if (sec == 1) { w.d0 = W2; w.r0 = n0 - 1024; }
        else if (sec < 4) { w.d0 = W2; w.r0 = 1024 + (n0 - 2048); }
        else if (sec < 6) { w.d0 = W1; w.r0 = 1024 + (n0 - 4096); }
        else if (sec == 6) { w.d0 = W1; w.r0 = 3072 + (n0 - 6144); }
        else if (sec == 7) { w.d0 = W2; w.r0 = 3072 + (n0 - 7168); }
        else if (sec == 8) { w.d0 = W1; w.r0 = 4096 + (n0 - 8192); }
        else { w.d0 = W1; w.r0 = 5120 + (n0 - 9216); }
    } else if (job < 768) { const int j = job - 640; w.src = P.in[5]; w.N = 1024; kt = j / 4; ntile = j % 4; w.ldk = 3072; w.d0 = (bf16_t*)(ws + OFF_WRET); w.r0 = ntile * 256; }
    else if (job < 832) { const int j = job - 768; w.src = P.in[10]; w.N = 1024; kt = j / 4; ntile = j % 4; w.ldk = 3072; w.d0 = (bf16_t*)(ws + OFF_WRET) + 2048; w.r0 = ntile * 256; }
    else if (job < 896) { const int j = job - 832; w.src = P.in[11]; w.N = 1024; kt = j / 4; ntile = j % 4; w.ldk = 1024; w.d0 = (bf16_t*)(ws + OFF_WO); w.r0 = ntile * 256; }
    else if (job < 1248) { const int j = job - 896; w.src = P.in[13]; w.N = 5632; kt = j / 22; ntile = j % 22; w.ldk = 1024; w.d0 = (bf16_t*)(ws + OFF_WF1); w.ksc = P.in[12];
        const int n0 = ntile * 256; w.hi0 = 256; w.r0 = n0 < 2816 ? 2 * n0 : 2 * (n0 - 2816) + 128; }
    else { const int j = job - 1248; w.src = P.in[14]; w.N = 1024; kt = j / 4; ntile = j % 4; w.ldk = 2816; w.d0 = (bf16_t*)(ws + OFF_WF2); w.r0 = ntile * 256; }
    w.k0 = kt * 64; w.n0 = ntile * 256; return w;
}
DI void wjob_load(const WJob& w, int tid, f32x4 (&v)[8]) {
    const int n4 = (tid & 63) * 4, kb = tid >> 6;
#pragma unroll
    for (int i = 0; i < 8; ++i) v[i] = __builtin_nontemporal_load((const f32x4*)(w.src + (size_t)(w.k0 + kb + 8 * i) * w.N + w.n0 + n4));
}
DI void wjob_store(const WJob& w, int tid, const f32x4 (&v)[8], ldsp lds) {
    LAS float* tile = (LAS float*)lds;
    __syncthreads();
    { const int n4 = (tid & 63) * 4, kb = tid >> 6;
#pragma unroll
      for (int i = 0; i < 8; ++i) { const int k = kb + 8 * i; const float s = w.ksc ? w.ksc[w.k0 + k] : 1.f;
          tile[k * 257 + n4] = v[i][0] * s; tile[k * 257 + n4 + 1] = v[i][1] * s; tile[k * 257 + n4 + 2] = v[i][2] * s; tile[k * 257 + n4 + 3] = v[i][3] * s; } }
    __syncthreads();
#pragma unroll
    for (int i = 0; i < 4; ++i) { const int item = tid + 512 * i, n = item >> 3, seg = item & 7;
        float o[8];
#pragma unroll
        for (int e = 0; e < 8; ++e) o[e] = tile[(seg * 8 + e) * 257 + n];
        const u32x4 p = pack8(o);
        const long rl = (n & 127) + (long)(n >> 7) * w.hi0;
        *(u32x4*)(w.d0 + (size_t)(w.r0 + rl) * w.ldk + w.k0 + seg * 8) = p;
        if (w.d1) *(u32x4*)(w.d1 + (size_t)(w.r1 + rl) * w.ldk + w.k0 + seg * 8) = p; }
}

DI void wjobs(const Params& P, ldsp lds, int tid, int first, int stride, int last) {
    int job = first;
    if (job < last) {
        WJob w = wjob_decode(P, job); f32x4 v[8]; wjob_load(w, tid, v);
        for (;;) {
            const int nj = job + stride; const bool more = nj < last;
            WJob wn = w; f32x4 vn[8];
#pragma unroll
            for (int i = 0; i < 8; ++i) vn[i] = v[i];
            if (more) { wn = wjob_decode(P, nj); wjob_load(wn, tid, vn); }
            wjob_store(w, tid, v, lds);
            if (!more) break;
            w = wn; job = nj;
#pragma unroll
            for (int i = 0; i < 8; ++i) v[i] = vn[i];
        }
    }
}

DI void phase0(const Params& P, ldsp lds, int wb) {
    const int tid = opaque_tid(wb), G = gridDim.x;
    const size_t gtid = (size_t)blockIdx.x * 512 + tid, gsz = (size_t)G * 512;
    float* st = (float*)(P.ws + OFF_ST);
    for (size_t i = gtid; i < (size_t)MP * 8; i += gsz) st[i] = 0.f;
    float* rope = (float*)(P.ws + OFF_ROPE);
    for (size_t i = gtid; i < (size_t)2049 * 128; i += gsz) { const int pidx = (int)(i >> 7), j = (int)(i & 127);
        const double inv = dpow_int(0.9305720409296989, j);
        const double pos = pidx < 2048 ? (double)pidx : 16384.0;
        double rev = pos * inv * 0.15915494309189535; rev -= floor(rev);
        const float fr = (float)rev;
        rope[2 * i] = __builtin_amdgcn_cosf(fr); rope[2 * i + 1] = __builtin_amdgcn_sinf(fr); }
    { const int wave = tid >> 6, lane = tid & 63; bf16_t* XN = (bf16_t*)(P.ws + OFF_XN); const float* g = P.in[3];
      f32x4 gg[4];
#pragma unroll
      for (int i = 0; i < 4; ++i) gg[i] = *(const f32x4*)(g + lane * 16 + i * 4);
      for (int row0 = blockIdx.x * 8 + wave; row0 < MP; row0 += G * 8 * 4) {
          f32x4 v[4][4];
#pragma unroll
          for (int q = 0; q < 4; ++q) { const int row = row0 + q * G * 8;
              const float* xr = row < NP ? P.in[0] + (size_t)row * 1024 : P.in[1] + (size_t)(row < MR ? row - NP : 0) * 1024;
#pragma unroll
              for (int i = 0; i < 4; ++i) v[q][i] = (row < MR) ? __builtin_nontemporal_load((const f32x4*)(xr + lane * 16 + i * 4)) : (f32x4){0.f, 0.f, 0.f, 0.f}; }
#pragma unroll
          for (int q = 0; q < 4; ++q) { const int row = row0 + q * G * 8;
              float ss = 0.f;
#pragma unroll
              for (int i = 0; i < 4; ++i) ss += v[q][i][0] * v[q][i][0] + v[q][i][1] * v[q][i][1] + v[q][i][2] * v[q][i][2] + v[q][i][3] * v[q][i][3];
              ss = sum_x63(ss);
              const float rs = rsqrtf(ss * (1.f / 1024.f) + EPSF);
              float o[16];
#pragma unroll
              for (int i = 0; i < 4; ++i)
#pragma unroll
                  for (int e = 0; e < 4; ++e) o[i * 4 + e] = v[q][i][e] * rs * gg[i][e];
              if (row < MP) { *(u32x4*)(XN + (size_t)row * 1024 + lane * 16) = pack8(o); *(u32x4*)(XN + (size_t)row * 1024 + lane * 16 + 8) = pack8(o + 8); } } } }
    wjobs(P, lds, tid, blockIdx.x, G, 640);
}

DI void retention_scan(const Params& P, ldsp lds, int item, int wb) {
    const int tid = opaque_tid(wb), wid = tid >> 6, lane = tid & 63, r = lane & 31, hh = lane >> 5;
    const int xcd = item & 7, idx = item >> 3, pair = xcd * 4 + (idx >> 3), dvs = idx & 7, b = pair >> 2, h = pair & 3;
    constexpr int STS = 0, GAM = 33792;
    const bf16_t* KTF = (const bf16_t*)(P.ws + OFF_KT); const bf16_t* VF = (const bf16_t*)(P.ws + OFF_VT);
    bf16_t* STG = (bf16_t*)(P.ws + OFF_STG);
    LAS float* gam = (LAS float*)(lds + GAM);
    __syncthreads();
    if (tid <= 128) gam[tid] = (float)dpow_int(1.0 - __builtin_ldexp(1.0, -5 - h), tid);
    __syncthreads();
    const int dd = wid & 1, dkt = wid >> 1;
    float dec[8][8];
#pragma unroll
    for (int ks = 0; ks < 8; ++ks)
#pragma unroll
        for (int e = 0; e < 8; ++e) dec[ks][e] = gam[127 - (ks * 16 + hh * 8 + e)];
    const float g128 = gam[128];
    f32x16 Sacc[2];
#pragma unroll
    for (int i = 0; i < 16; ++i) { Sacc[0][i] = 0.f; Sacc[1][i] = 0.f; }
    bf16x8 a0[8], a1[8]; u32x4 vt[8];
    { const size_t cgh = (size_t)((b * 16) * 4 + h);
      const bf16_t* ka = KTF + (cgh * 8 + dkt) * 4096 + lane * 8; const bf16_t* vb = VF + (cgh * 16 + dvs * 2 + dd) * 4096 + lane * 8;
#pragma unroll
      for (int i = 0; i < 8; ++i) { a0[i] = *(const bf16x8*)(ka + i * 512); a1[i] = *(const bf16x8*)(ka + 4 * 4096 + i * 512); vt[i] = *(const u32x4*)(vb + i * 512); } }
    for (int c = 0; c < 16; ++c) {
        int cg1 = b * 16 + c + 1; asm volatile("" : "+s"(cg1));
        if (c > 0) {
            __syncthreads();
#pragma unroll
            for (int hf = 0; hf < 2; ++hf)
#pragma unroll
                for (int g = 0; g < 4; ++g) { const int dk = hf * 128 + dkt * 32 + 8 * g + 4 * hh;
                    u32x2 pk; pk[0] = cvt_pk_bf16(Sacc[hf][4 * g], Sacc[hf][4 * g + 1]); pk[1] = cvt_pk_bf16(Sacc[hf][4 * g + 2], Sacc[hf][4 * g + 3]);
                    *(LAS u32x2*)(lds + STS + (dd * 32 + r) * 528 + dk * 2) = pk; }
            __syncthreads();
            bf16_t* sg = STG + (size_t)(pair * 16 + c) * 131072 + (size_t)dvs * 2 * 8192;
#pragma unroll
            for (int i = 0; i < 4; ++i) { const int it = tid + 512 * i, rr = it & 31, d8 = (it >> 5) & 31, dt = it >> 10;
                *(u32x4*)(sg + (size_t)it * 8) = *(const LAS u32x4*)(lds + STS + (dt * 32 + rr) * 528 + d8 * 16); }
        }
#pragma unroll
        for (int i = 0; i < 16; ++i) { Sacc[0][i] *= g128; Sacc[1][i] *= g128; }
        const size_t cgh = (size_t)(cg1 * 4 + h);
        const bf16_t* ka = KTF + (cgh * 8 + dkt) * 4096 + lane * 8; const bf16_t* vb = VF + (cgh * 16 + dvs * 2 + dd) * 4096 + lane * 8;
#pragma unroll
        for (int ks = 0; ks < 8; ++ks) {
            float f[8]; unpack8(vt[ks], f);
#pragma unroll
            for (int e = 0; e < 8; ++e) f[e] *= dec[ks][e];
            const bf16x8 bv = __builtin_bit_cast(bf16x8, pack8(f));
            Sacc[0] = MFMA32(a0[ks], bv, Sacc[0]); Sacc[1] = MFMA32(a1[ks], bv, Sacc[1]);
            if (c + 1 < 16) { a0[ks] = *(const bf16x8*)(ka + ks * 512); a1[ks] = *(const bf16x8*)(ka + 4 * 4096 + ks * 512); vt[ks] = *(const u32x4*)(vb + ks * 512); }
        }
    }
    float* sp = P.out + OUT_SP + (size_t)(b * 4 + h) * 256 * 512 + dvs * 64 + dd * 32 + r;
#pragma unroll
    for (int hf = 0; hf < 2; ++hf)
#pragma unroll
        for (int i = 0; i < 16; ++i) { const int dk = hf * 128 + dkt * 32 + (i & 3) + 8 * (i >> 2) + 4 * hh; sp[(size_t)dk * 512] = Sacc[hf][i]; }
}

DI void ro_loadb(int ks, const bf16_t* vp, const bf16_t* sp, bf16x8 (&dst)[2]) {
    if (ks < 8) { dst[0] = *(const bf16x8*)(vp + ks * 512); dst[1] = *(const bf16x8*)(vp + 4096 + ks * 512); }
    else { dst[0] = *(const bf16x8*)(sp + (ks - 8) * 512); dst[1] = *(const bf16x8*)(sp + 8192 + (ks - 8) * 512); }
}
template <int NKS>
DI void ro_mainloop(f32x16 (&acc)[4][2], bf16x8 (&bb)[4][2], const bf16_t* vp, const bf16_t* sp, ldsp lds, int r, int hh) {
#pragma unroll
    for (int ks = 0; ks < NKS; ++ks) {
        const bf16x8 b0 = bb[ks & 3][0], b1 = bb[ks & 3][1];
        if (ks + 4 < NKS) ro_loadb(ks + 4, vp, sp, bb[ks & 3]);
#pragma unroll
        for (int a = 0; a < 4; ++a) { if (ks >= 8 || ks < 2 * (a + 1)) { const bf16x8 af = *(const LAS bf16x8*)(lds + (a * 32 + r) * 784 + (ks * 16 + hh * 8) * 2);
            acc[a][0] = MFMA32(b0, af, acc[a][0]); acc[a][1] = MFMA32(b1, af, acc[a][1]); } }
    }
}

DI void retention_out(const Params& P, ldsp lds, int item, int wb) {
    const int tid = opaque_tid(wb), wid = tid >> 6, lane = tid & 63, r = lane & 31, hh = lane >> 5;
    const int pair = item >> 4, c = item & 15, b = pair >> 2, h = pair & 3;
    int tok0 = b * 2048 + c * 128; asm volatile("" : "+s"(tok0));
    constexpr int AIM = 0, RSB = 100352, RSTD = 104448, GAM = 104960, GIN = 105488;
    const bf16_t* Q = (const bf16_t*)(P.ws + OFF_Q); const bf16_t* KF = (const bf16_t*)(P.ws + OFF_K); const bf16_t* VF = (const bf16_t*)(P.ws + OFF_VT);
    const bf16_t* STG = (const bf16_t*)(P.ws + OFF_STG); const bf16_t* SG = (const bf16_t*)(P.ws + OFF_SG); bf16_t* RO = (bf16_t*)(P.ws + OFF_RO);
    LAS float* gam = (LAS float*)(lds + GAM); LAS float* gin = (LAS float*)(lds + GIN); LAS float* rsb = (LAS float*)(lds + RSB); LAS float* rstd = (LAS float*)(lds + RSTD);
    const int cg = tok0 >> 7;
    const int tt = wid >> 1, ss0 = (wid & 1) * 2;
    const bf16_t* kp = KF + ((size_t)(cg * 4 + h) * 4 + ss0) * 8192 + lane * 8;
    const bf16_t* vp = VF + ((size_t)(cg * 4 + h) * 16 + wid * 2) * 4096 + lane * 8;
    const bf16_t* sp = STG + (size_t)(pair * 16 + c) * 131072 + (size_t)wid * 2 * 8192 + lane * 8;
    u32x4 qv[8];
#pragma unroll
    for (int i = 0; i < 8; ++i) { const int it = tid + 512 * i, row = it >> 5, seg = it & 31; qv[i] = __builtin_nontemporal_load((const u32x4*)(Q + (size_t)(tok0 + row) * 1024 + h * 256 + seg * 8)); }
    bf16x8 kk[4][2], bb[4][2];
#pragma unroll
    for (int ks = 0; ks < 4; ++ks) { kk[ks][0] = *(const bf16x8*)(kp + ks * 512); kk[ks][1] = *(const bf16x8*)(kp + 8192 + ks * 512); }
#pragma unroll
    for (int ks = 0; ks < 4; ++ks) ro_loadb(ks, vp, sp, bb[ks]);
    __syncthreads();
    if (tid <= 128) { const double p = dpow_int(1.0 - __builtin_ldexp(1.0, -5 - h), tid); gam[tid] = (float)p; if (tid >= 1) gin[tid - 1] = (float)(1.0 / p); }
    __syncthreads();
#pragma unroll
    for (int i = 0; i < 8; ++i) { const int it = tid + 512 * i, row = it >> 5, seg = it & 31;
        float f[8]; unpack8(qv[i], f); const float gq = gam[row + 1];
#pragma unroll
        for (int e = 0; e < 8; ++e) f[e] *= gq;
        *(LAS u32x4*)(lds + AIM + row * 784 + (128 + seg * 8) * 2) = pack8(f); }
    __syncthreads();
    {
        f32x16 sacc[2];
#pragma unroll
        for (int i = 0; i < 16; ++i) { sacc[0][i] = 0.f; sacc[1][i] = 0.f; }
        if (ss0 <= tt) {
#pragma unroll
            for (int ks = 0; ks < 16; ++ks) {
                const bf16x8 a0 = kk[ks & 3][0], a1 = kk[ks & 3][1];
                if (ks + 4 < 16) { kk[ks & 3][0] = *(const bf16x8*)(kp + (ks + 4) * 512); kk[ks & 3][1] = *(const bf16x8*)(kp + 8192 + (ks + 4) * 512); }
                const bf16x8 bq = *(const LAS bf16x8*)(lds + AIM + (tt * 32 + r) * 784 + (128 + ks * 16 + hh * 8) * 2);
                sacc[0] = MFMA32(a0, bq, sacc[0]); sacc[1] = MFMA32(a1, bq, sacc[1]); }
        }
#pragma unroll
        for (int u = 0; u < 2; ++u)
#pragma unroll
            for (int g = 0; g < 4; ++g) { float pv[4]; const int t = tt * 32 + r;
#pragma unroll
                for (int e = 0; e < 4; ++e) { const int s = (ss0 + u) * 32 + 8 * g + 4 * hh + e; pv[e] = (t >= s) ? sacc[u][4 * g + e] * gin[s] : 0.f; }
                u32x2 pk; pk[0] = cvt_pk_bf16(pv[0], pv[1]); pk[1] = cvt_pk_bf16(pv[2], pv[3]);
                *(LAS u32x2*)(lds + AIM + t * 784 + ((ss0 + u) * 32 + 8 * g + 4 * hh) * 2) = pk; }
    }
    __syncthreads();
    f32x16 acc[4][2];
#pragma unroll
    for (int a = 0; a < 4; ++a)
#pragma unroll
        for (int d = 0; d < 2; ++d)
#pragma unroll
            for (int i = 0; i < 16; ++i) acc[a][d][i] = 0.f;
    if (c > 0) ro_mainloop<24>(acc, bb, vp, sp, lds, r, hh); else ro_mainloop<8>(acc, bb, vp, sp, lds, r, hh);
#pragma unroll
    for (int a = 0; a < 4; ++a) { float q = 0.f;
#pragma unroll
        for (int d = 0; d < 2; ++d)
#pragma unroll
            for (int i = 0; i < 16; ++i) q += acc[a][d][i] * acc[a][d][i];
        q += shx<32>(q);
        if (hh == 0) rsb[(a * 32 + r) * 8 + wid] = q; }
    __syncthreads();
    if (tid < 128) { float s = 0.f;
#pragma unroll
        for (int w = 0; w < 8; ++w) s += rsb[tid * 8 + w];
        rstd[tid] = rsqrtf(s * (1.f / 512.f) + EPSF); }
    __syncthreads();
#pragma unroll
    for (int th = 0; th < 2; ++th) {
#pragma unroll
        for (int ah = 0; ah < 2; ++ah) { const int a = th * 2 + ah; const float rs = rstd[a * 32 + r];
#pragma unroll
            for (int d = 0; d < 2; ++d)
#pragma unroll
                for (int g = 0; g < 4; ++g) { u32x2 pk; pk[0] = cvt_pk_bf16(acc[a][d][4 * g] * rs, acc[a][d][4 * g + 1] * rs); pk[1] = cvt_pk_bf16(acc[a][d][4 * g + 2] * rs, acc[a][d][4 * g + 3] * rs);
                    *(LAS u32x2*)(lds + AIM + (ah * 32 + r) * 1032 + (wid * 64 + d * 32 + 8 * g + 4 * hh) * 2) = pk; } }
        __syncthreads();
#pragma unroll
        for (int i = 0; i < 8; ++i) { const int it = tid + 512 * i, row = it >> 6, seg = it & 63; const size_t tok = (size_t)tok0 + th * 64 + row;
            const u32x2 lo = *(const LAS u32x2*)(lds + AIM + row * 1032 + seg * 16), hi = *(const LAS u32x2*)(lds + AIM + row * 1032 + seg * 16 + 8);
            float o[8], g[8]; unpack8((u32x4){lo[0], lo[1], hi[0], hi[1]}, o); unpack8(__builtin_nontemporal_load((const u32x4*)(SG + tok * 2048 + h * 512 + seg * 8)), g);
#pragma unroll
            for (int e = 0; e < 8; ++e) o[e] *= g[e];
            *(u32x4*)(RO + tok * 3072 + h * 512 + seg * 8) = pack8(o); }
        __syncthreads();
    }
}

DI void retention_sample(const Params& P, ldsp lds, int item, int wb) {
    const int tid = opaque_tid(wb), lane = tid & 63;
    const int bs = item >> 2, h = item & 3; const size_t tok = (size_t)NP + bs;
    const bf16_t* Q = (const bf16_t*)(P.ws + OFF_Q); const bf16_t* Kk = (const bf16_t*)(P.ws + OFF_K); const bf16_t* VT = (const bf16_t*)(P.ws + OFF_VT);
    const bf16_t* SG = (const bf16_t*)(P.ws + OFF_SG); bf16_t* RO = (bf16_t*)(P.ws + OFF_RO);
    LAS float* QF = (LAS float*)lds; LAS float* KF = QF + 256; LAS float* VF = QF + 512; LAS float* RED = QF + 1024;
    __syncthreads();
    if (tid < 256) { QF[tid] = bf2f(Q[tok * 1024 + h * 256 + tid]); KF[tid] = bf2f(Kk[kf_idx((int)tok, h, tid)]); }
    VF[tid] = bf2f(VT[vf_idx((int)tok, h, tid)]);
    __syncthreads();
    float qk = 0.f;
#pragma unroll
    for (int i = 0; i < 4; ++i) qk += QF[lane + 64 * i] * KF[lane + 64 * i];
    qk = sum_x63(qk);
    const float gamma = 1.f - __builtin_ldexpf(1.f, -5 - h);
    const int dv4 = (tid & 127) * 4, kg = tid >> 7;
    const size_t sb = ((size_t)(bs * 4 + h) * 256 + kg * 64) * 512 + dv4;
    const f32x4* S0 = (const f32x4*)(P.in[2] + sb); f32x4* S1 = (f32x4*)(P.out + OUT_SS + sb);
    const f32x4 v4 = *(const LAS f32x4*)(VF + dv4);
    f32x4 a4 = (f32x4){0.f, 0.f, 0.f, 0.f};
    for (int i0 = 0; i0 < 64; i0 += 32) {
        f32x4 s[32];
#pragma unroll
        for (int i = 0; i < 32; ++i) s[i] = __builtin_nontemporal_load(S0 + (size_t)(i0 + i) * 128);
#pragma unroll
        for (int i = 0; i < 32; ++i) { const float q = QF[kg * 64 + i0 + i], k = KF[kg * 64 + i0 + i];
            a4 += q * s[i];
            __builtin_nontemporal_store(gamma * s[i] + k * v4, S1 + (size_t)(i0 + i) * 128); }
    }
    *(LAS f32x4*)(RED + kg * 512 + dv4) = a4;
    __syncthreads();
    const float qs = RED[tid] + RED[512 + tid] + RED[1024 + tid] + RED[1536 + tid];
    const float o = qk * VF[tid] + gamma * qs;
    float q2 = o * o;
    q2 = sum_x63(q2);
    __syncthreads();
    if (lane == 0) RED[tid >> 6] = q2;
    __syncthreads();
    float tot = 0.f;
#pragma unroll
    for (int w = 0; w < 8; ++w) tot += RED[w];
    const float rs = rsqrtf(tot * (1.f / 512.f) + EPSF);
    RO[tok * 3072 + h * 512 + tid] = f2bf(bf2f(SG[tok * 2048 + h * 512 + tid]) * o * rs);
}

DI void gmlp_prompt(const Params& P, ldsp lds, int item, int wb) {
    const int tid = opaque_tid(wb), wid = tid >> 6, lane = tid & 63, r = lane & 31, hh = lane >> 5;
    const int b = item >> 6, c = (item >> 2) & 15, g = item & 3;
    int tok0 = b * 2048 + c * 128; asm volatile("" : "+s"(tok0));
    constexpr int WS_ = 0, GV = 34816, MU = 104448, RS = 104960;
    const bf16_t* GVT = (const bf16_t*)(P.ws + OFF_GVT); const bf16_t* GU = (const bf16_t*)(P.ws + OFF_GU); bf16_t* GI = (bf16_t*)(P.ws + OFF_RO);
    const float* st = (const float*)(P.ws + OFF_ST); const float* lnsum = st + (size_t)MP * 4; const float* lnsq = st + (size_t)MP * 5;
    LAS float* mu = (LAS float*)(lds + MU); LAS float* rs = (LAS float*)(lds + RS);
    float s1 = 0.f, s2 = 0.f;
    if (tid < 128) { s1 = lnsum[tok0 + tid]; s2 = lnsq[tok0 + tid]; }
    u32x4 xg[8];
#pragma unroll
    for (int i = 0; i < 8; ++i) { const int it = tid + 512 * i, row = it >> 4, seg = it & 15; xg[i] = __builtin_nontemporal_load((const u32x4*)(GVT + (size_t)(g * 256 + row) * MP + tok0 + seg * 8)); }
    f32x4 wv[4][2];
    { const float* W = P.in[8] + (size_t)g * 16384;
#pragma unroll
      for (int i = 0; i < 4; ++i) { const int it = tid + 512 * i, t = it >> 4, seg = it & 15; wv[i][0] = *(const f32x4*)(W + t * 128 + seg * 8); wv[i][1] = *(const f32x4*)(W + t * 128 + seg * 8 + 4); } }
    __syncthreads();
    if (tid < 128) { const float m = s1 * (1.f / 1024.f); const float var = fmaxf(s2 * (1.f / 1024.f) - m * m, 0.f); mu[tid] = m; rs[tid] = rsqrtf(var + EPSF); }
#pragma unroll
    for (int i = 0; i < 4; ++i) { const int it = tid + 512 * i, t = it >> 4, seg = it & 15;
        float v[8] = {wv[i][0][0], wv[i][0][1], wv[i][0][2], wv[i][0][3], wv[i][1][0], wv[i][1][1], wv[i][1][2], wv[i][1][3]};
#pragma unroll
        for (int e = 0; e < 8; ++e) v[e] = (seg * 8 + e <= t) ? v[e] : 0.f;
        *(LAS u32x4*)(lds + WS_ + t * 272 + seg * 16) = pack8(v); }
    __syncthreads();
    { const float* lg = P.in[6] + g * 256; const float* lb = P.in[7] + g * 256;
#pragma unroll
      for (int i = 0; i < 8; ++i) { const int it = tid + 512 * i, row = it >> 4, seg = it & 15;
          float v[8]; unpack8(xg[i], v); const float a = lg[row], bb = lb[row];
#pragma unroll
          for (int e = 0; e < 8; ++e) v[e] = (v[e] - mu[seg * 8 + e]) * rs[seg * 8 + e] * a + bb;
          *(LAS u32x4*)(lds + GV + row * 272 + seg * 16) = pack8(v); } }
    __syncthreads();
    const int tt = wid & 3, cb = (wid >> 2) * 4;
    f32x16 acc[4];
#pragma unroll
    for (int u = 0; u < 4; ++u)
#pragma unroll
        for (int i = 0; i < 16; ++i) acc[u][i] = 0.f;
    for (int ks = 0; ks < 2 * (tt + 1); ++ks) { const int ko = (ks * 16 + hh * 8) * 2;
        const bf16x8 a = *(const LAS bf16x8*)(lds + WS_ + (tt * 32 + r) * 272 + ko);
#pragma unroll
        for (int u = 0; u < 4; ++u) { const bf16x8 bv = *(const LAS bf16x8*)(lds + GV + ((cb + u) * 32 + r) * 272 + ko); acc[u] = MFMA32(bv, a, acc[u]); } }
    const int tl = tt * 32 + r; const size_t tok = (size_t)tok0 + tl; const float bi = P.in[9][g * 128 + tl];
#pragma unroll
    for (int u = 0; u < 4; ++u)
#pragma unroll
        for (int q = 0; q < 4; ++q) { const int ch = g * 256 + (cb + u) * 32 + 8 * q + 4 * hh;
            const u32x2 gu = *(const u32x2*)(GU + tok * 1024 + ch);
            u32x2 o; o[0] = cvt_pk_bf16(bf_lo(gu[0]) * (acc[u][4 * q] + bi), bf_hi(gu[0]) * (acc[u][4 * q + 1] + bi));
            o[1] = cvt_pk_bf16(bf_lo(gu[1]) * (acc[u][4 * q + 2] + bi), bf_hi(gu[1]) * (acc[u][4 * q + 3] + bi));
            *(u32x2*)(GI + tok * 3072 + 2048 + ch) = o; }
}
DI void gmlp_sample(const Params& P, int wb) {
    const bf16_t* GVT = (const bf16_t*)(P.ws + OFF_GVT); const bf16_t* GU = (const bf16_t*)(P.ws + OFF_GU); bf16_t* GI = (bf16_t*)(P.ws + OFF_RO);
    const float* st = (const float*)(P.ws + OFF_ST); const float* lnsum = st + (size_t)MP * 4; const float* lnsq = st + (size_t)MP * 5;
    for (size_t i = (size_t)blockIdx.x * 512 + opaque_tid(wb); i < (size_t)NSAMP * 1024; i += (size_t)gridDim.x * 512) {
        const int bs = (int)(i >> 10), ch = (int)(i & 1023), g = ch >> 8; const size_t tok = (size_t)NP + bs;
        const float m = lnsum[tok] * (1.f / 1024.f), var = fmaxf(lnsq[tok] * (1.f / 1024.f) - m * m, 0.f), rstd = rsqrtf(var + EPSF);
        const float x = bf2f(GVT[(size_t)ch * MP + tok]);
        const float gvn = (x - m) * rstd * P.in[6][ch] + P.in[7][ch];
        P.out[OUT_GV + i] = gvn;
        const float mixed = P.in[8][(size_t)g * 16384] * gvn + P.in[9][g * 128];
        GI[tok * 3072 + 2048 + ch] = f2bf(bf2f(GU[tok * 1024 + ch]) * mixed);
    }
}

DI void fixup_merge(const Params& P, int wb) {
    const bf16_t* AR = (const bf16_t*)(P.ws + OFF_AR); const bf16_t* AG = (const bf16_t*)(P.ws + OFF_AG); bf16_t* MM = (bf16_t*)(P.ws + OFF_MM);
    const float* ar = (const float*)(P.ws + OFF_ACC); const float* ag = ar + 8 * 131072;
    for (size_t i = (size_t)blockIdx.x * 512 + opaque_tid(wb); i < (size_t)NSAMP * 1024; i += (size_t)gridDim.x * 512) {
        const size_t gi = (size_t)NP * 1024 + i;
        float sr = 0.f, sg = 0.f;
#pragma unroll
        for (int k = 0; k < 8; ++k) sr += ar[(size_t)k * 131072 + i];
#pragma unroll
        for (int k = 0; k < 4; ++k) sg += ag[(size_t)k * 131072 + i];
        MM[gi] = f2bf(bf2f(AR[gi]) * sr + bf2f(AG[gi]) * sg); }
}
DI void fixup_o(const Params& P, int wb) {
    const int tid = opaque_tid(wb), lane = tid & 63, gw = blockIdx.x * 8 + (tid >> 6);
    if (gw >= NSAMP) return;
    const float* ao = (const float*)(P.ws + OFF_ACC) + 12 * 131072 + (size_t)gw * 1024 + lane * 16;
    const float* xr = P.in[1] + (size_t)gw * 1024 + lane * 16;
    float* H = (float*)(P.ws + OFF_H) + (size_t)(NP + gw) * 1024 + lane * 16; bf16_t* HB = (bf16_t*)(P.ws + OFF_HB) + (size_t)(NP + gw) * 1024 + lane * 16;
    float v[16], ss = 0.f;
#pragma unroll
    for (int i = 0; i < 4; ++i) { f32x4 a = *(const f32x4*)(ao + 4 * i); const f32x4 x = *(const f32x4*)(xr + 4 * i);
#pragma unroll
        for (int k = 1; k < 4; ++k) a += *(const f32x4*)(ao + (size_t)k * 131072 + 4 * i);
#pragma unroll
        for (int e = 0; e < 4; ++e) { v[4 * i + e] = a[e] + x[e]; ss += v[4 * i + e] * v[4 * i + e]; }
        *(f32x4*)(H + 4 * i) = (f32x4){v[4 * i], v[4 * i + 1], v[4 * i + 2], v[4 * i + 3]}; }
    *(u32x4*)HB = pack8(v); *(u32x4*)(HB + 8) = pack8(v + 8);
    ss = sum_x63(ss);
    if (lane == 0) ((float*)(P.ws + OFF_ST))[(size_t)MP * 6 + NP + gw] = ss;
}
DI void final_norm(const Params& P, int wb) {
    const float* ss2 = (const float*)(P.ws + OFF_ST) + (size_t)MP * 7; const float* g = P.in[15];
    const int tid = opaque_tid(wb);
    const bf16_t* Y2 = (const bf16_t*)(P.ws + OFF_T1);
    for (size_t i = (size_t)blockIdx.x * 512 + tid; i < (size_t)NP * 128; i += (size_t)gridDim.x * 512) {
        const int row = (int)(i >> 7), c8 = (int)(i & 127) * 8;
        const float rs = rsqrtf(ss2[row] * (1.f / 1024.f) + EPSF);
        float v[8]; unpack8(__builtin_nontemporal_load((const u32x4*)(Y2 + (size_t)row * 1024 + c8)), v);
        const f32x4 g0 = *(const f32x4*)(g + c8), g1 = *(const f32x4*)(g + c8 + 4);
        *(f32x4*)(P.out + OUT_Y + (size_t)row * 1024 + c8) = (f32x4){v[0] * rs * g0[0], v[1] * rs * g0[1], v[2] * rs * g0[2], v[3] * rs * g0[3]};
        *(f32x4*)(P.out + OUT_Y + (size_t)row * 1024 + c8 + 4) = (f32x4){v[4] * rs * g1[0], v[5] * rs * g1[1], v[6] * rs * g1[2], v[7] * rs * g1[3]};
    }
    const int lane = tid & 63, gw = blockIdx.x * 8 + (tid >> 6);
    if (gw < NSAMP) {
        const float* af = (const float*)(P.ws + OFF_ACC) + 16 * 131072 + (size_t)gw * 1024 + lane * 16;
        const float* H = (const float*)(P.ws + OFF_H) + (size_t)(NP + gw) * 1024 + lane * 16;
        float v[16], ss = 0.f;
#pragma unroll
        for (int i = 0; i < 4; ++i) { f32x4 a = *(const f32x4*)(af + 4 * i); const f32x4 x = *(const f32x4*)(H + 4 * i);
#pragma unroll
            for (int k = 1; k < 11; ++k) a += *(const f32x4*)(af + (size_t)k * 131072 + 4 * i);
#pragma unroll
            for (int e = 0; e < 4; ++e) { v[4 * i + e] = a[e] + x[e]; ss += v[4 * i + e] * v[4 * i + e]; } }
        ss = sum_x63(ss);
        const float rs = rsqrtf(ss * (1.f / 1024.f) + EPSF);
        float* y = P.out + OUT_Y + (size_t)(NP + gw) * 1024 + lane * 16;
#pragma unroll
        for (int i = 0; i < 4; ++i) { const f32x4 gg = *(const f32x4*)(g + lane * 16 + 4 * i);
            *(f32x4*)(y + 4 * i) = (f32x4){v[4 * i] * rs * gg[0], v[4 * i + 1] * rs * gg[1], v[4 * i + 2] * rs * gg[2], v[4 * i + 3] * rs * gg[3]}; }
    }
}

#define XB_TMO      128
#define XB_XCNT(j)  (256  + 64 * (j))
#define XB_XSUB(j)  (1280 + 64 * (j))
#define XB_XGEN(j)  (2304 + 64 * (j))
#define XB_TOP      3328
#define XB_TOPGEN   3392
#define XCD_BAR_WORDS 3456
#define XB_SPIN_CAP (1u << 22)
DI unsigned xb_ld(unsigned* p)              { return __hip_atomic_load(p, __ATOMIC_RELAXED, __HIP_MEMORY_SCOPE_AGENT); }
DI unsigned xb_add(unsigned* p, unsigned v) { return __hip_atomic_fetch_add(p, v, __ATOMIC_RELAXED, __HIP_MEMORY_SCOPE_AGENT); }
DI unsigned xb_xcc_id() { return (unsigned)__builtin_amdgcn_s_getreg((3 << 11) | 20) & 0xFu; }
#define XB_SPIN(cond, bar) do { unsigned _sp = 0; while (cond) { __builtin_amdgcn_s_sleep(1); \
    if ((++_sp & 255u) == 0u) { if (xb_ld(&(bar)[XB_TMO])) break; if (_sp > XB_SPIN_CAP) { atomicAdd(&(bar)[XB_TMO], 1u); break; } } } } while (0)
struct XcdBarrier { unsigned* bar; unsigned x; volatile LAS unsigned* st; };
DI XcdBarrier xcd_barrier_post(unsigned* bar, volatile LAS unsigned* st, int wb) {
    XcdBarrier b; b.bar = bar; b.x = xb_xcc_id(); b.st = st;
    if (opaque_tid(wb) == 0) (void)xb_add(&bar[XB_XCNT(b.x)], 1u);
    return b;
}
DI void xcd_barrier_complete(unsigned* bar, unsigned x, unsigned& nloc, unsigned& nx) {
    const unsigned G = gridDim.x * gridDim.y * gridDim.z;
    unsigned sum, cnt, mine, sp = 0u;
    for (;;) {
        sum = 0u; cnt = 0u; mine = 0u;
#pragma unroll
        for (unsigned j = 0; j < 16; ++j) { const unsigned c = xb_ld(&bar[XB_XCNT(j)]); sum += c; cnt += (c > 0u) ? 1u : 0u; mine = (j == x) ? c : mine; }
        if (sum == G) break;
        __builtin_amdgcn_s_sleep(1);
        if ((++sp & 255u) == 0u) { if (xb_ld(&bar[XB_TMO])) break; if (sp > XB_SPIN_CAP) { atomicAdd(&bar[XB_TMO], 1u); break; } }
    }
    nloc = mine > 0u ? mine : 1u; nx = cnt > 0u ? cnt : 1u;
}
DI void xcd_barrier(const XcdBarrier& b, int wb) {
    asm volatile("s_waitcnt vmcnt(0)" ::: "memory");
    __syncthreads();
    if (opaque_tid(wb) == 0) {
        unsigned* bar = b.bar;
        __builtin_amdgcn_s_waitcnt(0);
        unsigned nloc = b.st[0], nx = b.st[1];
        if (nloc == 0u) { xcd_barrier_complete(bar, b.x, nloc, nx); b.st[0] = nloc; b.st[1] = nx; }
        const unsigned old = xb_add(&bar[XB_XSUB(b.x)], 1u);
        const unsigned gen = old / nloc;
        if (old + 1u == (gen + 1u) * nloc) {
            __builtin_amdgcn_fence(__ATOMIC_RELEASE, "agent");
            asm volatile("s_waitcnt vmcnt(0)" ::: "memory");
            const unsigned og = xb_add(&bar[XB_TOP], 1u);
            const unsigned tg = og / nx;
            if (og + 1u == (tg + 1u) * nx) xb_add(&bar[XB_TOPGEN], 1u);
            else XB_SPIN(xb_ld(&bar[XB_TOPGEN]) == tg, bar);
            __builtin_amdgcn_fence(__ATOMIC_ACQUIRE, "agent");
            xb_add(&bar[XB_XGEN(b.x)], 1u);
            asm volatile("s_waitcnt vmcnt(0)" ::: "memory");
        } else {
            XB_SPIN(xb_ld(&bar[XB_XGEN(b.x)]) == gen, bar);
            __builtin_amdgcn_fence(__ATOMIC_ACQUIRE, "agent");
            asm volatile("s_waitcnt vmcnt(0)" ::: "memory");
        }
    }
    __syncthreads();
}

__global__ void __launch_bounds__(512, 2) fwd_megakernel(Params P) {
    extern __shared__ __attribute__((aligned(16))) unsigned char shm[];
    ldsp lds = (ldsp)shm;
    cg::grid_group grid = cg::this_grid();
    const int G = gridDim.x, c = blockIdx.x;
    unsigned char* ws = P.ws;
#define RELAUNDER() asm volatile("" : "+s"(ws))
    float* st = (float*)(ws + OFF_ST);
    float* sso = st; float* lnsum = st + (size_t)MP * 4; float* lnsq = st + (size_t)MP * 5; float* ssh = st + (size_t)MP * 6; float* ssh2 = st + (size_t)MP * 7;
    const float* rope = (const float*)(ws + OFF_ROPE);
    const int wb = __builtin_amdgcn_readfirstlane((int)threadIdx.x);
    volatile LAS unsigned* bst = (volatile LAS unsigned*)(lds + LDS_BYTES - 16);
    { const int t = opaque_tid(wb); if (t < 2) bst[t] = 0u; }
    __syncthreads();
    const XcdBarrier xb = xcd_barrier_post((unsigned*)(ws + OFF_BAR), bst, wb);
#ifndef PROBE_MASK
#define PROBE_MASK 0
#endif
#ifndef PROBE_K
#define PROBE_K 4
#endif
    unsigned long long tp_acc = 0ull, tp0 = 0ull;
#define PH_BEGIN(k) do { if (PROBE_MASK & (1 << (k))) tp0 = __builtin_amdgcn_s_memrealtime(); } while (0)
#define PH_END(k) do { if (PROBE_MASK & (1 << (k))) tp_acc += __builtin_amdgcn_s_memrealtime() - tp0; } while (0)

    PH_BEGIN(0);
    phase0(P, lds, wb);
    if (P.ws == nullptr) grid.sync();
    xcd_barrier(xb, wb);
    PH_END(0); PH_BEGIN(1);
    {
        pg8::Gemm g1{(const bf16_t*)(ws + OFF_XN), (const bf16_t*)(ws + OFF_WT1), MP, 6144, 1024, 1024, 1024};
        pg8::Order s1; s1.init(MP, 6144, G, c);
        EpiIn1 e1{ws, rope};
        pg8::gemm_phase(lds, g1, s1, e1, wb);
        pg8::Gemm g2{(const bf16_t*)(ws + OFF_WT2), (const bf16_t*)(ws + OFF_XN), 4096, MP, 1024, 1024, 1024};
        pg8::Order s2; s2.init(4096, MP, G, (c + G - (s1.nwg % G)) % G);
        EpiIn2 e2{(bf16_t*)(ws + OFF_KT), (bf16_t*)(ws + OFF_VT), (bf16_t*)(ws + OFF_GVT), (bf16_t*)(ws + OFF_K), rope, lnsum, lnsq};
        pg8::gemm_phase(lds, g2, s2, e2, wb);
        const int n1 = s1.nwg % G, n2 = s2.nwg % G;
        if (n1 + n2 < G) { if (c >= n1 + n2) wjobs(P, lds, opaque_tid(wb), 640 + (c - n1 - n2), G - n1 - n2, 1424); }
        else wjobs(P, lds, opaque_tid(wb), 640 + c, G, 1424);
    }
    xcd_barrier(xb, wb);
    PH_END(1); PH_BEGIN(2);
    if (G == 256) {
        if (c < 128) { retention_scan(P, lds, c, wb); retention_scan(P, lds, c + 128, wb); }
        else { for (int item = c - 128; item < 512; item += 128) retention_sample(P, lds, item, wb); }
    } else {
        for (int item = c; item < 512; item += G) retention_sample(P, lds, item, wb);
        for (int item = c; item < 256; item += G) retention_scan(P, lds, item, wb);
    }
    {
        unsigned* q = (unsigned*)(ws + OFF_BAR) + XCD_BAR_WORDS + 16;
        LAS unsigned* tk = (LAS unsigned*)(lds + LDS_BYTES - 32);
        for (;;) {
            __syncthreads();
            if (opaque_tid(wb) == 0) tk[0] = __hip_atomic_fetch_add(q, 1u, __ATOMIC_RELAXED, __HIP_MEMORY_SCOPE_AGENT);
            __syncthreads();
            const int item = (int)tk[0];
            if (item >= 512) break;
            gmlp_prompt(P, lds, item, wb);
        }
    }
    gmlp_sample(P, wb);
    xcd_barrier(xb, wb);
    PH_END(2); PH_BEGIN(11);
    for (int item = c; item < 512; item += G) retention_out(P, lds, item, wb);
    {
        pg8::SplitOrder sr; sr.init(64, 12, G, c);
        pg8::Gemm g3{(const bf16_t*)(ws + OFF_RO), (const bf16_t*)(ws + OFF_WRET), MP, 1024, 256, 3072, 3072};
        EpiSplit e3{(float*)(ws + OFF_ACC)};
        pg8::gemm_phase(lds, g3, sr, e3, wb);
    }
    xcd_barrier(xb, wb);
    PH_END(11); PH_BEGIN(3);
    fixup_merge(P, wb);
    {
        pg8::Order s; s.init(NP, 1024, G, c);
        pg8::Gemm g1{(const bf16_t*)(ws + OFF_RO), (const bf16_t*)(ws + OFF_WRET), NP, 1024, 3072, 3072, 3072};
        EpiMerge e1{(const bf16_t*)(ws + OFF_AR), (const bf16_t*)(ws + OFF_AG), (bf16_t*)(ws + OFF_MM)};
        pg8::gemm_phase(lds, g1, s, e1, wb);
    }
    xcd_barrier(xb, wb);
    PH_END(3); PH_BEGIN(4);
    {
        pg8::Order s; s.init(NP, 1024, G, c);
        pg8::Gemm g{(const bf16_t*)(ws + OFF_MM), (const bf16_t*)(ws + OFF_WO), NP, 1024, 1024, 1024, 1024};
        EpiO e{P.in[0], P.in[1], (float*)(ws + OFF_H), (bf16_t*)(ws + OFF_HB), ssh};
        pg8::gemm_phase(lds, g, s, e, wb);
        pg8::SplitOrder so; so.init(64, 4, G, c);
        pg8::Gemm g2{(const bf16_t*)(ws + OFF_MM), (const bf16_t*)(ws + OFF_WO), MP, 1024, 256, 1024, 1024};
        EpiSplit e2{(float*)(ws + OFF_ACC) + 12 * 131072};
        pg8::gemm_phase(lds, g2, so, e2, wb);
    }
    xcd_barrier(xb, wb);
    fixup_o(P, wb);
    xcd_barrier(xb, wb);
    PH_END(4); PH_BEGIN(5);
    {
        pg8::Order s; s.init(MP, 5632, G, c);
        pg8::Gemm g{(const bf16_t*)(ws + OFF_HB), (const bf16_t*)(ws + OFF_WF1), MP, 5632, 1024, 1024, 1024};
        EpiF1 e{ssh, (bf16_t*)(ws + OFF_ACT)};
        pg8::gemm_phase(lds, g, s, e, wb);
    }
    xcd_barrier(xb, wb);
    PH_END(5); PH_BEGIN(6);
    {
        pg8::Order s; s.init(NP, 1024, G, c);
        pg8::Gemm g{(const bf16_t*)(ws + OFF_ACT), (const bf16_t*)(ws + OFF_WF2), NP, 1024, 2816, 2816, 2816};
        EpiF2 e{(const bf16_t*)(ws + OFF_HB), (bf16_t*)(ws + OFF_T1), ssh2};
        pg8::gemm_phase(lds, g, s, e, wb);
        pg8::SplitOrder sf; sf.init(64, 11, G, c);
        pg8::Gemm g2{(const bf16_t*)(ws + OFF_ACT), (const bf16_t*)(ws + OFF_WF2), MP, 1024, 256, 2816, 2816};
        EpiSplit e2{(float*)(ws + OFF_ACC) + 16 * 131072};
        pg8::gemm_phase(lds, g2, sf, e2, wb);
    }
    xcd_barrier(xb, wb);
    PH_END(6); PH_BEGIN(7);
    final_norm(P, wb);
    PH_END(7);
    if (PROBE_MASK != 0 && blockIdx.x == 0) {
        __syncthreads();
        const unsigned long long t_end = __builtin_amdgcn_s_memrealtime() + (unsigned long long)PROBE_K * tp_acc;
        while (__builtin_amdgcn_s_memrealtime() < t_end) __builtin_amdgcn_s_sleep(8);
    }
}

extern "C" void kernel_launch(void* const* d_in, const int* in_sizes, int n_in, void* d_out, int out_size, void* d_ws, size_t ws_size, hipStream_t stream) {
    static int grid_blocks = 0;
    if (!grid_blocks) {
        int dev = 0, cus = 0, per_cu = 0;
        (void)hipGetDevice(&dev);
        (void)hipDeviceGetAttribute(&cus, hipDeviceAttributeMultiprocessorCount, dev);
        (void)hipFuncSetAttribute((const void*)fwd_megakernel, hipFuncAttributeMaxDynamicSharedMemorySize, LDS_BYTES);
        (void)hipOccupancyMaxActiveBlocksPerMultiprocessor(&per_cu, (const void*)fwd_megakernel, 512, LDS_BYTES);
        if (per_cu < 1) per_cu = 1;
        if (cus < 1) cus = 256;
        grid_blocks = cus * per_cu;
        if (ws_size < WS_END) fprintf(stderr, "kernel_launch: workspace too small: %zu < %zu\n", ws_size, (size_t)WS_END);
    }
    Params p{};
    for (int i = 0; i < 16; ++i) p.in[i] = (const float*)d_in[i];
    p.out = (float*)d_out; p.ws = (unsigned char*)d_ws;
    (void)hipMemsetAsync((unsigned char*)d_ws + OFF_BAR, 0, 16384, stream);
    void* args[] = {&p};
    hipError_t e = hipLaunchCooperativeKernel((const void*)fwd_megakernel, dim3(grid_blocks), dim3(512), args, LDS_BYTES, stream);
    if (e != hipSuccess) fprintf(stderr, "cooperative launch failed: %s (grid %d)\n", hipGetErrorString(e), grid_blocks);
}
```

```cpp
#include <hip/hip_runtime.h>
#include <hip/hip_cooperative_groups.h>
#include <cstdio>
namespace cg = cooperative_groups;

#define LAS __attribute__((address_space(3)))
#define DI __device__ __forceinline__
typedef unsigned short bf16_t;
typedef short bf16x8 __attribute__((ext_vector_type(8)));
typedef float f32x4 __attribute__((ext_vector_type(4)));
typedef float f32x2 __attribute__((ext_vector_type(2)));
typedef float f32x16 __attribute__((ext_vector_type(16)));
typedef unsigned u32x4 __attribute__((ext_vector_type(4)));
typedef unsigned u32x2 __attribute__((ext_vector_type(2)));
typedef LAS unsigned char* ldsp;

constexpr int NP = 16384, NSAMP = 128, MR = NP + NSAMP, MP = 16640;
constexpr int LDS_BYTES = 147456;
constexpr float EPSF = 1e-6f;

constexpr size_t SZ_MP1024_BF = (size_t)MP * 1024 * 2;
constexpr size_t OFF_XN = 0;
constexpr size_t OFF_WT1 = OFF_XN + SZ_MP1024_BF;
constexpr size_t OFF_WT2 = OFF_WT1 + (size_t)7168 * 1024 * 2;
constexpr size_t OFF_WRET = OFF_WT2 + (size_t)4096 * 1024 * 2;
constexpr size_t OFF_WGM = OFF_WRET + (size_t)1024 * 2048 * 2;
constexpr size_t OFF_WO = OFF_WGM + (size_t)1024 * 1024 * 2;
constexpr size_t OFF_WF1 = OFF_WO + (size_t)1024 * 1024 * 2;
constexpr size_t OFF_WF2 = OFF_WF1 + (size_t)5632 * 1024 * 2;
constexpr size_t OFF_Q = OFF_WF2 + (size_t)1024 * 2816 * 2;
constexpr size_t OFF_K = OFF_Q + SZ_MP1024_BF;
constexpr size_t OFF_SG = OFF_K + SZ_MP1024_BF;
constexpr size_t OFF_GU = OFF_SG + 2 * SZ_MP1024_BF;
constexpr size_t OFF_AR = OFF_GU + SZ_MP1024_BF;
constexpr size_t OFF_AG = OFF_AR + SZ_MP1024_BF;
constexpr size_t OFF_KT = OFF_AG + SZ_MP1024_BF;
constexpr size_t OFF_VT = OFF_KT + SZ_MP1024_BF;
constexpr size_t OFF_GVT = OFF_VT + 2 * SZ_MP1024_BF;
constexpr size_t OFF_RO = OFF_GVT + SZ_MP1024_BF;
constexpr size_t OFF_GI = OFF_RO + 2 * SZ_MP1024_BF;
constexpr size_t OFF_T1 = OFF_GI + SZ_MP1024_BF;
constexpr size_t OFF_MM = OFF_T1 + 2 * SZ_MP1024_BF;
constexpr size_t OFF_H = OFF_MM + SZ_MP1024_BF;
constexpr size_t OFF_HB = OFF_H + 2 * SZ_MP1024_BF;
constexpr size_t OFF_ACT = OFF_HB + SZ_MP1024_BF;
constexpr size_t OFF_ST = OFF_ACT + (size_t)MP * 2816 * 2;
constexpr size_t OFF_ROPE = OFF_ST + (size_t)MP * 8 * 4;
constexpr size_t OFF_BAR = OFF_ROPE + (size_t)2049 * 128 * 8;
constexpr size_t OFF_STG = OFF_BAR + 16384;
constexpr size_t OFF_ACC = OFF_STG + (size_t)32 * 16 * 512 * 256 * 2;
constexpr size_t WS_END = OFF_ACC + (size_t)27 * 128 * 1024 * 4;

constexpr size_t OUT_Y = 0;
constexpr size_t OUT_SP = (size_t)MR * 1024;
constexpr size_t OUT_SS = OUT_SP + (size_t)8 * 4 * 256 * 512;
constexpr size_t OUT_GV = OUT_SS + (size_t)128 * 4 * 256 * 512;

struct Params {
    const float* in[16];
    float* out;
    unsigned char* ws;
};

DI unsigned cvt_pk_bf16(float lo, float hi) { unsigned r; asm("v_cvt_pk_bf16_f32 %0, %1, %2" : "=v"(r) : "v"(lo), "v"(hi)); return r; }
DI float bf_lo(unsigned v) { return __uint_as_float(v << 16); }
DI float bf_hi(unsigned v) { return __uint_as_float(v & 0xffff0000u); }
DI float bf2f(bf16_t b) { return __uint_as_float(((unsigned)b) << 16); }
DI bf16_t f2bf(float f) { return (bf16_t)(cvt_pk_bf16(f, 0.f) & 0xffffu); }
DI u32x4 pack8(const float* v) { u32x4 p; p[0] = cvt_pk_bf16(v[0], v[1]); p[1] = cvt_pk_bf16(v[2], v[3]); p[2] = cvt_pk_bf16(v[4], v[5]); p[3] = cvt_pk_bf16(v[6], v[7]); return p; }
DI void unpack8(u32x4 p, float* v) { v[0] = bf_lo(p[0]); v[1] = bf_hi(p[0]); v[2] = bf_lo(p[1]); v[3] = bf_hi(p[1]); v[4] = bf_lo(p[2]); v[5] = bf_hi(p[2]); v[6] = bf_lo(p[3]); v[7] = bf_hi(p[3]); }
DI float fsigmoid(float x) { return __builtin_amdgcn_rcpf(1.f + __expf(-x)); }
DI float fsilu(float x) { return x * fsigmoid(x); }
DI float fgelu(float x) { const float u = 0.7978845608028654f * (x + 0.044715f * x * x * x); return x * fsigmoid(2.f * u); }
DI int opaque_tid(int wb) { int t = wb + (int)__builtin_amdgcn_mbcnt_hi(~0u, __builtin_amdgcn_mbcnt_lo(~0u, 0u)); asm volatile("" : "+v"(t)); return t; }
#define MFMA32(a, b, c) __builtin_amdgcn_mfma_f32_32x32x16_bf16((a), (b), (c), 0, 0, 0)

template <int M> DI float shx(float v) {
    if constexpr (M < 32) return __int_as_float(__builtin_amdgcn_ds_swizzle(__float_as_int(v), (M << 10) | 0x1f));
    else { int l = (int)__builtin_amdgcn_mbcnt_hi(~0u, __builtin_amdgcn_mbcnt_lo(~0u, 0u)); asm volatile("" : "+v"(l));
           return __int_as_float(__builtin_amdgcn_ds_bpermute((l ^ 32) << 2, __float_as_int(v))); }
}
DI float sum_x15(float v) { v += shx<1>(v); v += shx<2>(v); v += shx<4>(v); v += shx<8>(v); return v; }
DI float sum_x31(float v) { v = sum_x15(v); v += shx<16>(v); return v; }
DI float sum_x63(float v) { v = sum_x31(v); v += shx<32>(v); return v; }

DI size_t kf_idx(int tok, int h, int d) { const int cg = tok >> 7, s = tok & 127, d8 = d >> 3;
    return ((((((size_t)(cg * 4 + h) * 4 + (s >> 5)) * 16 + (d8 >> 1)) * 2 + (d8 & 1)) * 32 + (s & 31)) * 8) + (d & 7); }
DI size_t ktf_idx(int tok, int h, int dk) { const int cg = tok >> 7, s = tok & 127, s8 = s >> 3;
    return ((((((size_t)(cg * 4 + h) * 8 + (dk >> 5)) * 8 + (s8 >> 1)) * 2 + (s8 & 1)) * 32 + (dk & 31)) * 8) + (s & 7); }
DI size_t vf_idx(int tok, int h, int dv) { const int cg = tok >> 7, s = tok & 127, s8 = s >> 3;
    return ((((((size_t)(cg * 4 + h) * 16 + (dv >> 5)) * 8 + (s8 >> 1)) * 2 + (s8 & 1)) * 32 + (dv & 31)) * 8) + (s & 7); }

namespace pg8 {
constexpr int BM = 256, BK = 64, HALF = 128, HTB = HALF * BK * 2, STAGE_BYTES = 8 * HTB, NXCD = 8, WGM = 8;
DI int lds_byte(int r, int c) { const int st = (r >> 4) * 2 + (c >> 5), rr = r & 15, cc = c & 31, ob = rr * 64 + cc * 2; return st * 1024 + (ob ^ (((ob >> 9) & 1) << 5)); }
DI void stage_rc(int b, int& R, int& C) { const int st = b / 1024, sb = b % 1024, swz = sb ^ (((sb >> 9) & 1) << 5); R = (st >> 1) * 16 + swz / 64; C = (st & 1) * 32 + (swz % 64) / 2; }
DI int perm32(int rho) { const int n = rho >> 4, i = rho & 15; return 8 * (i >> 2) + 4 * n + (i & 3); }
struct Unit { int pm, pn, pk; };
struct Gemm { const bf16_t* A; const bf16_t* Bt; int M, N, K, lda, ldb; };
struct Order {
    int nM, nN, nwg, G, c;
    DI void init(int M, int N, int G_, int c_) { nM = M / BM; nN = N / BM; nwg = nM * nN; G = G_; c = c_; }
    DI bool next(int i, Unit& u) const {
        const long L = (long)i * G + c; if (L >= nwg) return false;
        int wgid = (int)L; { const int q = nwg / NXCD, r = nwg % NXCD, xcd = wgid % NXCD, off = wgid / NXCD; wgid = (xcd < r ? xcd * (q + 1) : r * (q + 1) + (xcd - r) * q) + off; }
        const int nig = WGM * nN, gid = wgid / nig, fm = gid * WGM, gsz = (nM - fm) < WGM ? (nM - fm) : WGM;
        u.pm = fm + ((wgid % nig) % gsz); u.pn = (wgid % nig) / gsz; u.pk = 0; return true;
    }
};
struct SplitOrder {
    int nunits, G, c, pm;
    DI void init(int pm_, int nsplit, int G_, int c_) { pm = pm_; nunits = 4 * nsplit; G = G_; c = c_; }
    DI bool next(int i, Unit& u) const { const int L = i * G + c; if (L >= nunits) return false; u.pm = pm; u.pn = L & 3; u.pk = L >> 2; return true; }
};

template <class Epi, class Sched>
DI void gemm_phase(ldsp lds, const Gemm g, const Sched& S, const Epi& E, int wb) {
    const int tid = opaque_tid(wb), wid = __builtin_amdgcn_readfirstlane(tid >> 6), lane = tid & 63, wr = wid >> 2, wc = wid & 3, fr = lane & 15, fq = lane >> 4;
    const int K = g.K, nt = K / BK;
    unsigned voffA[2], voffB[2];
#pragma unroll
    for (int i = 0; i < 2; ++i) { int R, C; stage_rc(tid * 16 + i * 8192, R, C); const int Rb = Epi::PERM ? ((R & ~31) + perm32(R & 31)) : R;
        voffA[i] = (unsigned)(R * g.lda + C) * 2u; voffB[i] = (unsigned)(Rb * g.ldb + C) * 2u; }
    const size_t kstep = (size_t)(BK * 2);
    const size_t hstepA = (size_t)HALF * g.lda * 2, hstepB = (size_t)HALF * g.ldb * 2;
    const size_t tstepA = 2 * hstepA, tstepB = 2 * hstepB, kslice = (size_t)K * 2;
    const unsigned ldsw = (unsigned)wid * 1024u;
    const int aoff = lds_byte(wr * 64 + fr, fq * 8), boff = lds_byte(wc * 32 + fr, fq * 8);
#define PG8_SA(b, h) (((b) * 2 + (h)) * HTB)
#define PG8_SB(b, h) ((4 + (b) * 2 + (h)) * HTB)
#define PG8_STAGE(bufoff, gbase, voff) do { _Pragma("unroll") for (int _i = 0; _i < 2; ++_i) \
        __builtin_amdgcn_global_load_lds((const unsigned*)((const char*)(gbase) + (voff)[_i]), (LAS unsigned*)(lds + (bufoff) + ldsw + _i * 8192), 16, 0, 0); } while (0)
#define PG8_LDA(dst, b, h) do { _Pragma("unroll") for (int m = 0; m < 4; ++m) _Pragma("unroll") for (int k = 0; k < 2; ++k) dst[m][k] = *(const LAS bf16x8*)(lds + PG8_SA(b, h) + aoff + m * 2048 + k * 1024); } while (0)
#define PG8_LDB(dst, b, h) do { _Pragma("unroll") for (int n = 0; n < 2; ++n) _Pragma("unroll") for (int k = 0; k < 2; ++k) dst[n][k] = *(const LAS bf16x8*)(lds + PG8_SB(b, h) + boff + n * 2048 + k * 1024); } while (0)
#define PG8_MMA(ai, bj, At, Bt) do { __builtin_amdgcn_s_setprio(1); _Pragma("unroll") for (int m = 0; m < 4; ++m) _Pragma("unroll") for (int n = 0; n < 2; ++n) _Pragma("unroll") for (int k = 0; k < 2; ++k) \
        acc[ai][bj][m][n] = __builtin_amdgcn_mfma_f32_16x16x32_bf16(Bt[n][k], At[m][k], acc[ai][bj][m][n], 0, 0, 0); __builtin_amdgcn_s_setprio(0); } while (0)
#define PG8_WAIT_V(n) asm volatile("s_waitcnt vmcnt(" #n ")" ::: "memory")
#define PG8_WAIT_L(n) asm volatile("s_waitcnt lgkmcnt(" #n ")" ::: "memory")
#define PG8_BAR __builtin_amdgcn_s_barrier()
#define PG8_SCHED __builtin_amdgcn_sched_barrier(0)
    Unit cur, nxt; int ui = 0;
    if (!S.next(0, cur)) return;
    f32x4 acc[2][2][4][2];
#pragma unroll
    for (int a = 0; a < 2; ++a)
#pragma unroll
        for (int b = 0; b < 2; ++b)
#pragma unroll
            for (int m = 0; m < 4; ++m)
#pragma unroll
                for (int n = 0; n < 2; ++n) acc[a][b][m][n] = (f32x4){0.f, 0.f, 0.f, 0.f};
    bf16x8 At[4][2], B0[2][2], B1[2][2];
    const char* cA = (const char*)g.A + (size_t)cur.pm * tstepA + (size_t)cur.pk * kslice; const char* cB = (const char*)g.Bt + (size_t)cur.pn * tstepB + (size_t)cur.pk * kslice;
    PG8_STAGE(PG8_SB(0, 0), cB, voffB); PG8_STAGE(PG8_SA(0, 0), cA, voffA); PG8_STAGE(PG8_SB(0, 1), cB + hstepB, voffB); PG8_STAGE(PG8_SA(0, 1), cA + hstepA, voffA);
    if (wr == 1) PG8_BAR;
    PG8_WAIT_V(4); PG8_BAR;
    PG8_STAGE(PG8_SB(1, 0), cB + kstep, voffB); PG8_STAGE(PG8_SA(1, 0), cA + kstep, voffA); PG8_STAGE(PG8_SB(1, 1), cB + hstepB + kstep, voffB);
    PG8_WAIT_V(6); PG8_BAR;
    for (;;) {
        const bool has_next = S.next(ui + 1, nxt);
        const char* nA = has_next ? (const char*)g.A + (size_t)nxt.pm * tstepA + (size_t)nxt.pk * kslice : cA; const char* nB = has_next ? (const char*)g.Bt + (size_t)nxt.pn * tstepB + (size_t)nxt.pk * kslice : cB;
        for (int t = 0; t < nt; t += 2) {
            const bool last = (t == nt - 2);
            const char* a1 = cA + (size_t)(t + 1) * kstep;
            const char* a2 = last ? nA : cA + (size_t)(t + 2) * kstep; const char* b2 = last ? nB : cB + (size_t)(t + 2) * kstep;
            const char* a3 = a2 + kstep; const char* b3 = b2 + kstep;
            PG8_LDB(B0, 0, 0); PG8_SCHED; PG8_LDA(At, 0, 0); PG8_STAGE(PG8_SA(1, 1), a1 + hstepA, voffA);
            PG8_WAIT_L(8); PG8_BAR; PG8_WAIT_L(0); PG8_MMA(0, 0, At, B0); PG8_BAR; PG8_SCHED;
            PG8_LDB(B1, 0, 1); PG8_STAGE(PG8_SB(0, 0), b2, voffB);
            PG8_BAR; PG8_WAIT_L(0); PG8_MMA(0, 1, At, B1); PG8_BAR;
            PG8_LDA(At, 0, 1); PG8_STAGE(PG8_SA(0, 0), a2, voffA);
            PG8_BAR; PG8_WAIT_L(0); PG8_MMA(1, 0, At, B0); PG8_BAR; PG8_SCHED;
            PG8_STAGE(PG8_SB(0, 1), b2 + hstepB, voffB);
            PG8_WAIT_V(6); PG8_BAR; PG8_MMA(1, 1, At, B1); PG8_BAR;
            PG8_LDB(B0, 1, 0); PG8_SCHED; PG8_LDA(At, 1, 0); PG8_STAGE(PG8_SA(0, 1), a2 + hstepA, voffA);
            PG8_WAIT_L(8); PG8_BAR; PG8_WAIT_L(0); PG8_MMA(0, 0, At, B0); PG8_BAR; PG8_SCHED;
            PG8_LDB(B1, 1, 1); PG8_STAGE(PG8_SB(1, 0), b3, voffB);
            PG8_BAR; PG8_WAIT_L(0); PG8_MMA(0, 1, At, B1); PG8_BAR;
            PG8_LDA(At, 1, 1); PG8_STAGE(PG8_SA(1, 0), a3, voffA);
            PG8_BAR; PG8_WAIT_L(0); PG8_MMA(1, 0, At, B0); PG8_BAR; PG8_SCHED;
            PG8_STAGE(PG8_SB(1, 1), b3 + hstepB, voffB);
            PG8_WAIT_V(6); PG8_BAR; PG8_MMA(1, 1, At, B1); PG8_BAR;
            if constexpr (Epi::KHOOK) { if (t + 2 == Epi::KHOOK_AT) { int fr2 = fr, fq2 = fq; asm volatile("" : "+v"(fr2), "+v"(fq2)); E.khook(acc, cur, t, wr, wc, fr2, fq2); } }
        }
        { int fr2 = fr, fq2 = fq; asm volatile("" : "+v"(fr2), "+v"(fq2));
          E(acc, cur, wr, wc, fr2, fq2); }
        if (!has_next) break;
#pragma unroll
        for (int a = 0; a < 2; ++a)
#pragma unroll
            for (int b = 0; b < 2; ++b)
#pragma unroll
                for (int m = 0; m < 4; ++m)
#pragma unroll
                    for (int n = 0; n < 2; ++n) acc[a][b][m][n] = (f32x4){0.f, 0.f, 0.f, 0.f};
        cur = nxt; cA = nA; cB = nB; ++ui;
    }
    PG8_WAIT_V(0);
    if (wr == 0) PG8_BAR;
    PG8_BAR;
#undef PG8_SA
#undef PG8_SB
#undef PG8_STAGE
#undef PG8_LDA
#undef PG8_LDB
#undef PG8_MMA
#undef PG8_WAIT_V
#undef PG8_WAIT_L
#undef PG8_BAR
#undef PG8_SCHED
}
}
using pg8::Unit;
typedef f32x4 Acc[2][2][4][2];
#define EPI_UNROLL _Pragma("unroll")
DI void acc8(const Acc& acc, int ai, int bj, int m, float* v) {
    v[0] = acc[ai][bj][m][0][0]; v[1] = acc[ai][bj][m][0][1]; v[2] = acc[ai][bj][m][0][2]; v[3] = acc[ai][bj][m][0][3];
    v[4] = acc[ai][bj][m][1][0]; v[5] = acc[ai][bj][m][1][1]; v[6] = acc[ai][bj][m][1][2]; v[7] = acc[ai][bj][m][1][3];
}

struct EpiIn1 {
    static constexpr bool PERM = true, KHOOK = false;
    unsigned char* ws; const float* rope;
    DI void operator()(const Acc& acc, const Unit& u, int wr, int wc, int fr, int fq) const {
        const int pn = u.pn, row0 = u.pm * 256 + wr * 64 + fr, cl = wc * 32 + 8 * fq;
        if (pn < 4) {
            bf16_t* dst = (bf16_t*)(ws + OFF_Q); const int cb = pn * 256;
            f32x4 cr[4], nr[4];
            { const int row = row0, pidx = row < NP ? (row & 2047) : 2048; const f32x4* rp = (const f32x4*)(rope + ((size_t)pidx * 128 + cl) * 2);
              EPI_UNROLL for (int q = 0; q < 4; ++q) cr[q] = rp[q]; }
            EPI_UNROLL for (int it = 0; it < 8; ++it) { const int ai = it >> 2, m = it & 3; const int row = row0 + ai * 128 + m * 16;
                if (it < 7) { const int nrow = row0 + ((it + 1) >> 2) * 128 + ((it + 1) & 3) * 16, pidx = nrow < NP ? (nrow & 2047) : 2048;
                    const f32x4* rp = (const f32x4*)(rope + ((size_t)pidx * 128 + cl) * 2);
                    EPI_UNROLL for (int q = 0; q < 4; ++q) nr[q] = rp[q]; }
                float x1[8], x2[8], o1[8], o2[8]; acc8(acc, ai, 0, m, x1); acc8(acc, ai, 1, m, x2);
                EPI_UNROLL for (int q = 0; q < 4; ++q) { const f32x4 cs = cr[q];
                    o1[2 * q] = x1[2 * q] * cs[0] - x2[2 * q] * cs[1]; o2[2 * q] = x1[2 * q] * cs[1] + x2[2 * q] * cs[0];
                    o1[2 * q + 1] = x1[2 * q + 1] * cs[2] - x2[2 * q + 1] * cs[3]; o2[2 * q + 1] = x1[2 * q + 1] * cs[3] + x2[2 * q + 1] * cs[2]; }
                bf16_t* rowp = dst + (size_t)row * 1024 + cb + cl; *(u32x4*)rowp = pack8(o1); *(u32x4*)(rowp + 128) = pack8(o2);
                EPI_UNROLL for (int q = 0; q < 4; ++q) cr[q] = nr[q];
                __builtin_amdgcn_sched_barrier(0);
            }
        } else {
            size_t doff; int ld, cb, mode;
            if (pn < 12) { doff = OFF_SG; ld = 2048; cb = (pn - 4) * 256; mode = 0; }
            else if (pn < 16) { doff = OFF_GU; ld = 1024; cb = (pn - 12) * 256; mode = 1; }
            else if (pn < 20) { doff = OFF_AR; ld = 1024; cb = (pn - 16) * 256; mode = 2; }
            else { doff = OFF_AG; ld = 1024; cb = (pn - 20) * 256; mode = 2; }
            bf16_t* dst = (bf16_t*)(ws + doff);
            EPI_UNROLL for (int ai = 0; ai < 2; ++ai) EPI_UNROLL for (int m = 0; m < 4; ++m) {
                const int row = row0 + ai * 128 + m * 16;
                EPI_UNROLL for (int bj = 0; bj < 2; ++bj) { float v[8]; acc8(acc, ai, bj, m, v);
                    if (mode == 0) { EPI_UNROLL for (int e = 0; e < 8; ++e) v[e] = fsilu(v[e]); }
                    else if (mode == 1) { EPI_UNROLL for (int e = 0; e < 8; ++e) v[e] = fgelu(v[e]); }
                    else { EPI_UNROLL for (int e = 0; e < 8; ++e) v[e] = fsigmoid(v[e]); }
                    *(u32x4*)(dst + (size_t)row * ld + cb + bj * 128 + cl) = pack8(v); }
            }
        }
    }
};
struct EpiIn2 {
    static constexpr bool PERM = true, KHOOK = false;
    bf16_t *KT, *VT, *GVT, *KF; const float* rope; float *lnsum, *lnsq;
    DI void operator()(const Acc& acc, const Unit& u, int wr, int wc, int fr, int fq) const {
        const int pm = u.pm, tl = wc * 32 + 8 * fq;
        if (pm < 4) {
            f32x2 cs[8], ns[8];
            { const int tok = u.pn * 256 + tl, j = wr * 64 + fr; const int pbase = tok < NP ? (tok & 2047) : 2048, pinc = tok < NP ? 1 : 0;
              EPI_UNROLL for (int e = 0; e < 8; ++e) cs[e] = *(const f32x2*)(rope + ((size_t)(pbase + pinc * e) * 128 + j) * 2); }
            EPI_UNROLL for (int it = 0; it < 8; ++it) { const int m = it >> 1, bj = it & 1; const int j = wr * 64 + m * 16 + fr; const int tok = u.pn * 256 + bj * 128 + tl;
                if (it < 7) { const int nm = (it + 1) >> 1, nb = (it + 1) & 1; const int nj = wr * 64 + nm * 16 + fr, ntok = u.pn * 256 + nb * 128 + tl;
                    const int pbase = ntok < NP ? (ntok & 2047) : 2048, pinc = ntok < NP ? 1 : 0;
                    EPI_UNROLL for (int e = 0; e < 8; ++e) ns[e] = *(const f32x2*)(rope + ((size_t)(pbase + pinc * e) * 128 + nj) * 2); }
                EPI_UNROLL for (int hf = 0; hf < 2; ++hf) {
                    float x1[8], x2[8], o[8]; acc8(acc, 0, bj, m, x1); acc8(acc, 1, bj, m, x2);
                    EPI_UNROLL for (int e = 0; e < 8; ++e) o[e] = (hf == 0 ? (x1[e] * cs[e][0] - x2[e] * cs[e][1]) : (x1[e] * cs[e][1] + x2[e] * cs[e][0])) * 0.0625f;
                    *(u32x4*)(KT + ktf_idx(tok, pm, hf * 128 + j)) = pack8(o);
#define TR_STAGE(KK) { const bool up = (fr & KK) != 0; EPI_UNROLL for (int e = 0; e < 8; ++e) { if ((e & KK) == 0) { \
                        const float a = o[e], b = o[e ^ KK]; const float rcv = shx<KK>(up ? a : b); o[e] = up ? rcv : a; o[e ^ KK] = up ? b : rcv; } } }
                    TR_STAGE(4) TR_STAGE(2) TR_STAGE(1)
#undef TR_STAGE
                    *(u32x4*)(KF + kf_idx(tok + (fr & 7), pm, hf * 128 + wr * 64 + m * 16 + (fr & 8))) = pack8(o); }
                EPI_UNROLL for (int e = 0; e < 8; ++e) cs[e] = ns[e];
                __builtin_amdgcn_sched_barrier(0); }
        } else if (pm < 12) {
            EPI_UNROLL for (int ai = 0; ai < 2; ++ai) EPI_UNROLL for (int m = 0; m < 4; ++m) { const int r = (pm - 4) * 256 + ai * 128 + wr * 64 + m * 16 + fr;
                EPI_UNROLL for (int bj = 0; bj < 2; ++bj) { float v[8]; acc8(acc, ai, bj, m, v);
                    *(u32x4*)(VT + vf_idx(u.pn * 256 + bj * 128 + tl, r >> 9, r & 511)) = pack8(v); } }
        } else {
            EPI_UNROLL for (int bj = 0; bj < 2; ++bj) {
                float s1[8], s2[8];
                EPI_UNROLL for (int e = 0; e < 8; ++e) { s1[e] = 0.f; s2[e] = 0.f; }
                EPI_UNROLL for (int ai = 0; ai < 2; ++ai) EPI_UNROLL for (int m = 0; m < 4; ++m) { const int r = (pm - 12) * 256 + ai * 128 + wr * 64 + m * 16 + fr;
                    float v[8]; acc8(acc, ai, bj, m, v);
                    EPI_UNROLL for (int e = 0; e < 8; ++e) { v[e] = fgelu(v[e]); s1[e] += v[e]; s2[e] += v[e] * v[e]; }
                    *(u32x4*)(GVT + (size_t)r * MP + u.pn * 256 + bj * 128 + tl) = pack8(v); __builtin_amdgcn_sched_barrier(0); }
                EPI_UNROLL for (int e = 0; e < 8; ++e) {
                    float a = s1[e], b = s2[e];
                    a = sum_x15(a); b = sum_x15(b);
                    if (fr == 0) { const int tok = u.pn * 256 + bj * 128 + tl + e; unsafeAtomicAdd(lnsum + tok, a); unsafeAtomicAdd(lnsq + tok, b); } }
                __builtin_amdgcn_sched_barrier(0);
            }
        }
    }
};
struct EpiMerge {
    static constexpr bool PERM = true, KHOOK = true; static constexpr int KHOOK_AT = 32;
    const bf16_t* AR; const bf16_t* AG; bf16_t* MM;
    DI void khook(Acc& acc, const Unit& u, int t, int wr, int wc, int fr, int fq) const {
        const size_t base = (size_t)(u.pm * 256 + wr * 64 + fr) * 1024 + u.pn * 256 + wc * 32 + 8 * fq;
        EPI_UNROLL for (int it = 0; it < 8; ++it) { const int ai = it >> 2, m = it & 3; const size_t off = base + (size_t)(ai * 128 + m * 16) * 1024;
            EPI_UNROLL for (int bj = 0; bj < 2; ++bj) { float a[8], g[8]; unpack8(*(const u32x4*)(AR + off + bj * 128), a); unpack8(*(const u32x4*)(AG + off + bj * 128), g);
                EPI_UNROLL for (int e = 0; e < 4; ++e) { acc[ai][bj][m][0][e] *= a[e] * __builtin_amdgcn_rcpf(fmaxf(g[e], 1e-20f)); acc[ai][bj][m][1][e] *= a[4 + e] * __builtin_amdgcn_rcpf(fmaxf(g[4 + e], 1e-20f)); } }
            __builtin_amdgcn_sched_barrier(0); }
    }
    DI void operator()(const Acc& acc, const Unit& u, int wr, int wc, int fr, int fq) const {
        const size_t base = (size_t)(u.pm * 256 + wr * 64 + fr) * 1024 + u.pn * 256 + wc * 32 + 8 * fq;
        u32x4 cg[2], ng[2];
        cg[0] = *(const u32x4*)(AG + base); cg[1] = *(const u32x4*)(AG + base + 128);
        EPI_UNROLL for (int it = 0; it < 8; ++it) { const int ai = it >> 2, m = it & 3; const size_t off = base + (size_t)(ai * 128 + m * 16) * 1024;
            if (it < 7) { const size_t no = base + (size_t)(((it + 1) >> 2) * 128 + ((it + 1) & 3) * 16) * 1024; ng[0] = *(const u32x4*)(AG + no); ng[1] = *(const u32x4*)(AG + no + 128); }
            EPI_UNROLL for (int bj = 0; bj < 2; ++bj) { float v[8], g[8]; acc8(acc, ai, bj, m, v); unpack8(cg[bj], g);
                EPI_UNROLL for (int e = 0; e < 8; ++e) v[e] *= fmaxf(g[e], 1e-20f);
                *(u32x4*)(MM + off + bj * 128) = pack8(v); }
            cg[0] = ng[0]; cg[1] = ng[1]; __builtin_amdgcn_sched_barrier(0); }
    }
};
struct EpiO {
    static constexpr bool PERM = true, KHOOK = false;
    const float *xp, *xs; float* H; bf16_t* HB; float* ssh;
    DI void operator()(const Acc& acc, const Unit& u, int wr, int wc, int fr, int fq) const {
        const int row0 = u.pm * 256 + wr * 64 + fr;
        const size_t base = (size_t)row0 * 1024 + u.pn * 256 + wc * 32 + 8 * fq;
        f32x4 cx[4], nx[4];
        EPI_UNROLL for (int bj = 0; bj < 2; ++bj) { cx[2 * bj] = __builtin_nontemporal_load((const f32x4*)(xp + base + bj * 128)); cx[2 * bj + 1] = __builtin_nontemporal_load((const f32x4*)(xp + base + bj * 128 + 4)); }
        EPI_UNROLL for (int it = 0; it < 8; ++it) { const int ai = it >> 2, m = it & 3; const size_t off = base + (size_t)(ai * 128 + m * 16) * 1024;
            if (it < 7) { const size_t no = base + (size_t)(((it + 1) >> 2) * 128 + ((it + 1) & 3) * 16) * 1024;
                EPI_UNROLL for (int bj = 0; bj < 2; ++bj) { nx[2 * bj] = __builtin_nontemporal_load((const f32x4*)(xp + no + bj * 128)); nx[2 * bj + 1] = __builtin_nontemporal_load((const f32x4*)(xp + no + bj * 128 + 4)); } }
            float ss = 0.f;
            EPI_UNROLL for (int bj = 0; bj < 2; ++bj) { float v[8]; acc8(acc, ai, bj, m, v);
                EPI_UNROLL for (int e = 0; e < 4; ++e) { v[e] += cx[2 * bj][e]; v[4 + e] += cx[2 * bj + 1][e]; }
                EPI_UNROLL for (int e = 0; e < 8; ++e) ss += v[e] * v[e];
                *(u32x4*)(HB + off + bj * 128) = pack8(v); }
            ss += shx<16>(ss); ss += shx<32>(ss);
            if (fq == 0) unsafeAtomicAdd(ssh + row0 + ai * 128 + m * 16, ss);
            EPI_UNROLL for (int q = 0; q < 4; ++q) cx[q] = nx[q];
            __builtin_amdgcn_sched_barrier(0); }
    }
};
struct EpiF1 {
    static constexpr bool PERM = true, KHOOK = false;
    const float* ssh; bf16_t* ACT;
    DI void operator()(const Acc& acc, const Unit& u, int wr, int wc, int fr, int fq) const {
        EPI_UNROLL for (int ai = 0; ai < 2; ++ai) EPI_UNROLL for (int m = 0; m < 4; ++m) { const int row = u.pm * 256 + ai * 128 + wr * 64 + m * 16 + fr;
            const float rs = rsqrtf(ssh[row] * (1.f / 1024.f) + EPSF);
            float g[8], p[8]; acc8(acc, ai, 0, m, g); acc8(acc, ai, 1, m, p);
            EPI_UNROLL for (int e = 0; e < 8; ++e) g[e] = fsilu(g[e] * rs) * (p[e] * rs);
            *(u32x4*)(ACT + (size_t)row * 2816 + u.pn * 128 + wc * 32 + 8 * fq) = pack8(g); }
    }
};
struct EpiF2 {
    static constexpr bool PERM = true, KHOOK = false;
    const bf16_t* HB; bf16_t* Y2; float* ssh2;
    DI void operator()(const Acc& acc, const Unit& u, int wr, int wc, int fr, int fq) const {
        const int row0 = u.pm * 256 + wr * 64 + fr;
        const size_t base = (size_t)row0 * 1024 + u.pn * 256 + wc * 32 + 8 * fq;
        u32x4 cx[2], nx[2];
        cx[0] = __builtin_nontemporal_load((const u32x4*)(HB + base)); cx[1] = __builtin_nontemporal_load((const u32x4*)(HB + base + 128));
        EPI_UNROLL for (int it = 0; it < 8; ++it) { const int ai = it >> 2, m = it & 3; const size_t off = base + (size_t)(ai * 128 + m * 16) * 1024;
            if (it < 7) { const size_t no = base + (size_t)(((it + 1) >> 2) * 128 + ((it + 1) & 3) * 16) * 1024; nx[0] = __builtin_nontemporal_load((const u32x4*)(HB + no)); nx[1] = __builtin_nontemporal_load((const u32x4*)(HB + no + 128)); }
            float ss = 0.f;
            EPI_UNROLL for (int bj = 0; bj < 2; ++bj) { float v[8], h[8]; acc8(acc, ai, bj, m, v); unpack8(cx[bj], h);
                EPI_UNROLL for (int e = 0; e < 8; ++e) { v[e] += h[e]; ss += v[e] * v[e]; }
                *(u32x4*)(Y2 + off + bj * 128) = pack8(v); }
            ss += shx<16>(ss); ss += shx<32>(ss);
            if (fq == 0) unsafeAtomicAdd(ssh2 + row0 + ai * 128 + m * 16, ss);
            cx[0] = nx[0]; cx[1] = nx[1];
            __builtin_amdgcn_sched_barrier(0); }
    }
};
struct EpiSplit {
    static constexpr bool PERM = true, KHOOK = false;
    float* SLAB;
    DI void operator()(const Acc& acc, const Unit& u, int wr, int wc, int fr, int fq) const {
        float* sl = SLAB + (size_t)u.pk * 131072;
        EPI_UNROLL for (int m = 0; m < 4; ++m) { const int row = wr * 64 + m * 16 + fr;
            EPI_UNROLL for (int bj = 0; bj < 2; ++bj) { const int col = u.pn * 256 + bj * 128 + wc * 32 + 8 * fq;
                *(f32x4*)(sl + (size_t)row * 1024 + col) = acc[0][bj][m][0]; *(f32x4*)(sl + (size_t)row * 1024 + col + 4) = acc[0][bj][m][1]; } }
    }
};

DI double dpow_int(double base, int n) { double r = 1.0; for (int b = 0; b < 8; ++b) { if ((n >> b) & 1) r *= base; base *= base; } return r; }

struct WJob { const float* src; const float* ksc; bf16_t* d0; bf16_t* d1; int N, k0, n0, ldk, hi0; long r0, r1; };
DI WJob wjob_decode(const Params& P, int job) {
    WJob w; w.ksc = nullptr; w.d0 = nullptr; w.d1 = nullptr; w.hi0 = 128; w.r0 = 0; w.r1 = 0;
    int kt, ntile; unsigned char* ws = P.ws;
    if (job < 640) { w.src = P.in[4]; w.N = 10240; kt = job / 40; ntile = job % 40; w.ldk = 1024;
        const int n0 = ntile * 256, sec = n0 >> 10;
        bf16_t* W1 = (bf16_t*)(ws + OFF_WT1); bf16_t* W2 = (bf16_t*)(ws + OFF_WT2);
        if (sec == 0) { w.d0 = W1; w.r0 = n0; }
        else if (sec == 1) { w.d0 = W2; w.r0 = n0 - 1024; }
        else if (sec < 4) { w.d0 = W2; w.r0 = 1024 + (n0 - 2048); }
        else if (sec < 6) { w.d0 = W1; w.r0 = 1024 + (n0 - 4096); }
        else if (sec == 6) { w.d0 = W1; w.r0 = 3072 + (n0 - 6144); }
        else if (sec == 7) { w.d0 = W2; w.r0 = 3072 + (n0 - 7168); }
        else if (sec == 8) { w.d0 = W1; w.r0 = 4096 + (n0 - 8192); }
        else { w.d0 = W1; w.r0 = 5120 + (n0 - 9216); }
    } else if (job < 768) { const int j = job - 640; w.src = P.in[5]; w.N = 1024; kt = j / 4; ntile = j % 4; w.ldk = 3072; w.d0 = (bf16_t*)(ws + OFF_WRET); w.r0 = ntile * 256; }
    else if (job < 832) { const int j = job - 768; w.src = P.in[10]; w.N = 1024; kt = j / 4; ntile = j % 4; w.ldk = 3072; w.d0 = (bf16_t*)(ws + OFF_WRET) + 2048; w.r0 = ntile * 256; }
    else if (job < 896) { const int j = job - 832; w.src = P.in[11]; w.N = 1024; kt = j / 4; ntile = j % 4; w.ldk = 1024; w.d0 = (bf16_t*)(ws + OFF_WO); w.r0 = ntile * 256; }
    else if (job < 1248) { const int j = job - 896; w.src = P.in[13]; w.N = 5632; kt = j / 22; ntile = j % 22; w.ldk = 1024; w.d0 = (bf16_t*)(ws + OFF_WF1); w.ksc = P.in[12];
        const int n0 = ntile * 256; w.hi0 = 256; w.r0 = n0 < 2816 ? 2 * n0 : 2 * (n0 - 2816) + 128; }
    else { const int j = job - 1248; w.src = P.in[14]; w.N = 1024; kt = j / 4; ntile = j % 4; w.ldk = 2816; w.d0 = (bf16_t*)(ws + OFF_WF2); w.r0 = ntile * 256; }
    w.k0 = kt * 64; w.n0 = ntile * 256; return w;
}
DI void wjob_load(const WJob& w, int tid, f32x4 (&v)[8]) {
    const int n4 = (tid & 63) * 4, kb = tid >> 6;
#pragma unroll
    for (int i = 0; i < 8; ++i) v[i] = __builtin_nontemporal_load((const f32x4*)(w.src + (size_t)(w.k0 + kb + 8 * i) * w.N + w.n0 + n4));
}
DI void wjob_store(const WJob& w, int tid, const f32x4 (&v)[8], ldsp lds) {
    LAS float* tile = (LAS float*)lds;
    __syncthreads();
    { const int n4 = (tid & 63) * 4, kb = tid >> 6;
#pragma unroll
      for (int i = 0; i < 8; ++i) { const int k = kb + 8 * i; const float s = w.ksc ? w.ksc[w.k0 + k] : 1.f;
          tile[k * 257 + n4] = v[i][0] * s; tile[k * 257 + n4 + 1] = v[i][1] * s; tile[k * 257 + n4 + 2] = v[i][2] * s; tile[k * 257 + n4 + 3] = v[i][3] * s; } }
    __syncthreads();
#pragma unroll
    for (int i = 0; i < 4; ++i) { const int item = tid + 512 * i, n = item >> 3, seg = item & 7;
        float o[8];
#pragma unroll
        for (int e = 0; e < 8; ++e) o[e] = tile[(seg * 8 + e) * 257 + n];
        const u32x4 p = pack8(o);
        const long rl = (n & 127) + (long)(n >> 7) * w.hi0;
        *(u32x4*)(w.d0 + (size_t)(w.r0 + rl) * w.ldk + w.k0 + seg * 8) = p;
        if (w.d1) *(u32x4*)(w.d1 + (size_t)(w.r1 + rl) * w.ldk + w.k0 + seg * 8) = p; }
}

DI void wjobs(const Params& P, ldsp lds, int tid, int first, int stride, int last) {
    int job = first;
    if (job < last) {
        WJob w = wjob_decode(P, job); f32x4 v[8]; wjob_load(w, tid, v);
        for (;;) {
            const int nj = job + stride; const bool more = nj < last;
            WJob wn = w; f32x4 vn[8];
#pragma unroll
            for (int i = 0; i < 8; ++i) vn[i] = v[i];
            if (more) { wn = wjob_decode(P, nj); wjob_load(wn, tid, vn); }
            wjob_store(w, tid, v, lds);
            if (!more) break;
            w = wn; job = nj;
#pragma unroll
            for (int i = 0; i < 8; ++i) v[i] = vn[i];
        }
    }
}

DI void phase0(const Params& P, ldsp lds, int wb) {
    const int tid = opaque_tid(wb), G = gridDim.x;
    const size_t gtid = (size_t)blockIdx.x * 512 + tid, gsz = (size_t)G * 512;
    float* st = (float*)(P.ws + OFF_ST);
    for (size_t i = gtid; i < (size_t)MP * 8; i += gsz) st[i] = 0.f;
    float* rope = (float*)(P.ws + OFF_ROPE);
    for (size_t i = gtid; i < (size_t)2049 * 128; i += gsz) { const int pidx = (int)(i >> 7), j = (int)(i & 127);
        const double inv = dpow_int(0.9305720409296989, j);
        const double pos = pidx < 2048 ? (double)pidx : 16384.0;
        double rev = pos * inv * 0.15915494309189535; rev -= floor(rev);
        const float fr = (float)rev;
        rope[2 * i] = __builtin_amdgcn_cosf(fr); rope[2 * i + 1] = __builtin_amdgcn_sinf(fr); }
    { const int wave = tid >> 6, lane = tid & 63; bf16_t* XN = (bf16_t*)(P.ws + OFF_XN); const float* g = P.in[3];
      f32x4 gg[4];
#pragma unroll
      for (int i = 0; i < 4; ++i) gg[i] = *(const f32x4*)(g + lane * 16 + i * 4);
      for (int row0 = blockIdx.x * 8 + wave; row0 < MP; row0 += G * 8 * 4) {
          f32x4 v[4][4];
#pragma unroll
          for (int q = 0; q < 4; ++q) { const int row = row0 + q * G * 8;
              const float* xr = row < NP ? P.in[0] + (size_t)row * 1024 : P.in[1] + (size_t)(row < MR ? row - NP : 0) * 1024;
#pragma unroll
              for (int i = 0; i < 4; ++i) v[q][i] = (row < MR) ? __builtin_nontemporal_load((const f32x4*)(xr + lane * 16 + i * 4)) : (f32x4){0.f, 0.f, 0.f, 0.f}; }
#pragma unroll
          for (int q = 0; q < 4; ++q) { const int row = row0 + q * G * 8;
              float ss = 0.f;
#pragma unroll
              for (int i = 0; i < 4; ++i) ss += v[q][i][0] * v[q][i][0] + v[q][i][1] * v[q][i][1] + v[q][i][2] * v[q][i][2] + v[q][i][3] * v[q][i][3];
              ss = sum_x63(ss);
              const float rs = rsqrtf(ss * (1.f / 1024.f) + EPSF);
              float o[16];
#pragma unroll
              for (int i = 0; i < 4; ++i)
#pragma unroll
                  for (int e = 0; e < 4; ++e) o[i * 4 + e] = v[q][i][e] * rs * gg[i][e];
              if (row < MP) { *(u32x4*)(XN + (size_t)row * 1024 + lane * 16) = pack8(o); *(u32x4*)(XN + (size_t)row * 1024 + lane * 16 + 8) = pack8(o + 8); } } } }
    wjobs(P, lds, tid, blockIdx.x, G, 640);
}

DI void retention_scan(const Params& P, ldsp lds, int item, int wb) {
    const int tid = opaque_tid(wb), wid = tid >> 6, lane = tid & 63, r = lane & 31, hh = lane >> 5;
    const int xcd = item & 7, idx = item >> 3, pair = xcd * 4 + (idx >> 3), dvs = idx & 7, b = pair >> 2, h = pair & 3;
    constexpr int STS = 0, GAM = 33792;
    const bf16_t* KTF = (const bf16_t*)(P.ws + OFF_KT); const bf16_t* VF = (const bf16_t*)(P.ws + OFF_VT);
    bf16_t* STG = (bf16_t*)(P.ws + OFF_STG);
    LAS float* gam = (LAS float*)(lds + GAM);
    __syncthreads();
    if (tid <= 128) gam[tid] = (float)dpow_int(1.0 - __builtin_ldexp(1.0, -5 - h), tid);
    __syncthreads();
    const int dd = wid & 1, dkt = wid >> 1;
    float dec[8][8];
#pragma unroll
    for (int ks = 0; ks < 8; ++ks)
#pragma unroll
        for (int e = 0; e < 8; ++e) dec[ks][e] = gam[127 - (ks * 16 + hh * 8 + e)];
    const float g128 = gam[128];
    f32x16 Sacc[2];
#pragma unroll
    for (int i = 0; i < 16; ++i) { Sacc[0][i] = 0.f; Sacc[1][i] = 0.f; }
    bf16x8 a0[8], a1[8]; u32x4 vt[8];
    { const size_t cgh = (size_t)((b * 16) * 4 + h);
      const bf16_t* ka = KTF + (cgh * 8 + dkt) * 4096 + lane * 8; const bf16_t* vb = VF + (cgh * 16 + dvs * 2 + dd) * 4096 + lane * 8;
#pragma unroll
      for (int i = 0; i < 8; ++i) { a0[i] = *(const bf16x8*)(ka + i * 512); a1[i] = *(const bf16x8*)(ka + 4 * 4096 + i * 512); vt[i] = *(const u32x4*)(vb + i * 512); } }
    for (int c = 0; c < 16; ++c) {
        int cg1 = b * 16 + c + 1; asm volatile("" : "+s"(cg1));
        if (c > 0) {
            __syncthreads();
#pragma unroll
            for (int hf = 0; hf < 2; ++hf)
#pragma unroll
                for (int g = 0; g < 4; ++g) { const int dk = hf * 128 + dkt * 32 + 8 * g + 4 * hh;
                    u32x2 pk; pk[0] = cvt_pk_bf16(Sacc[hf][4 * g], Sacc[hf][4 * g + 1]); pk[1] = cvt_pk_bf16(Sacc[hf][4 * g + 2], Sacc[hf][4 * g + 3]);
                    *(LAS u32x2*)(lds + STS + (dd * 32 + r) * 528 + dk * 2) = pk; }
            __syncthreads();
            bf16_t* sg = STG + (size_t)(pair * 16 + c) * 131072 + (size_t)dvs * 2 * 8192;
#pragma unroll
            for (int i = 0; i < 4; ++i) { const int it = tid + 512 * i, rr = it & 31, d8 = (it >> 5) & 31, dt = it >> 10;
                *(u32x4*)(sg + (size_t)it * 8) = *(const LAS u32x4*)(lds + STS + (dt * 32 + rr) * 528 + d8 * 16); }
        }
#pragma unroll
        for (int i = 0; i < 16; ++i) { Sacc[0][i] *= g128; Sacc[1][i] *= g128; }
        const size_t cgh = (size_t)(cg1 * 4 + h);
        const bf16_t* ka = KTF + (cgh * 8 + dkt) * 4096 + lane * 8; const bf16_t* vb = VF + (cgh * 16 + dvs * 2 + dd) * 4096 + lane * 8;
#pragma unroll
        for (int ks = 0; ks < 8; ++ks) {
            float f[8]; unpack8(vt[ks], f);
#pragma unroll
            for (int e = 0; e < 8; ++e) f[e] *= dec[ks][e];
            const bf16x8 bv = __builtin_bit_cast(bf16x8, pack8(f));
            Sacc[0] = MFMA32(a0[ks], bv, Sacc[0]); Sacc[1] = MFMA32(a1[ks], bv, Sacc[1]);
            if (c + 1 < 16) { a0[ks] = *(const bf16x8*)(ka + ks * 512); a1[ks] = *(const bf16x8*)(ka + 4 * 4096 + ks * 512); vt[ks] = *(const u32x4*)(vb + ks * 512); }
        }
    }
    float* sp = P.out + OUT_SP + (size_t)(b * 4 + h) * 256 * 512 + dvs * 64 + dd * 32 + r;
#pragma unroll
    for (int hf = 0; hf < 2; ++hf)
#pragma unroll
        for (int i = 0; i < 16; ++i) { const int dk = hf * 128 + dkt * 32 + (i & 3) + 8 * (i >> 2) + 4 * hh; sp[(size_t)dk * 512] = Sacc[hf][i]; }
}

DI void ro_loadb(int ks, const bf16_t* vp, const bf16_t* sp, bf16x8 (&dst)[2]) {
    if (ks < 8) { dst[0] = *(const bf16x8*)(vp + ks * 512); dst[1] = *(const bf16x8*)(vp + 4096 + ks * 512); }
    else { dst[0] = __builtin_nontemporal_load((const bf16x8*)(sp + (ks - 8) * 512)); dst[1] = __builtin_nontemporal_load((const bf16x8*)(sp + 8192 + (ks - 8) * 512)); }
}
template <int NKS>
DI void ro_mainloop(f32x16 (&acc)[4][2], bf16x8 (&bb)[4][2], const bf16_t* vp, const bf16_t* sp, ldsp lds, int r, int hh) {
#pragma unroll
    for (int ks = 0; ks < NKS; ++ks) {
        const bf16x8 b0 = bb[ks & 3][0], b1 = bb[ks & 3][1];
        if (ks + 4 < NKS) ro_loadb(ks + 4, vp, sp, bb[ks & 3]);
#pragma unroll
        for (int a = 0; a < 4; ++a) { if (ks >= 8 || ks < 2 * (a + 1)) { const bf16x8 af = *(const LAS bf16x8*)(lds + (a * 32 + r) * 784 + (ks * 16 + hh * 8) * 2);
            acc[a][0] = MFMA32(b0, af, acc[a][0]); acc[a][1] = MFMA32(b1, af, acc[a][1]); } }
    }
}

DI void retention_out(const Params& P, ldsp lds, int item, int wb) {
    const int tid = opaque_tid(wb), wid = tid >> 6, lane = tid & 63, r = lane & 31, hh = lane >> 5;
    const int pair = item >> 4, c = item & 15, b = pair >> 2, h = pair & 3;
    int tok0 = b * 2048 + c * 128; asm volatile("" : "+s"(tok0));
    constexpr int AIM = 0, RSB = 100352, RSTD = 104448, GAM = 104960, GIN = 105488;
    const bf16_t* Q = (const bf16_t*)(P.ws + OFF_Q); const bf16_t* KF = (const bf16_t*)(P.ws + OFF_K); const bf16_t* VF = (const bf16_t*)(P.ws + OFF_VT);
    const bf16_t* STG = (const bf16_t*)(P.ws + OFF_STG); const bf16_t* SG = (const bf16_t*)(P.ws + OFF_SG); bf16_t* RO = (bf16_t*)(P.ws + OFF_RO);
    LAS float* gam = (LAS float*)(lds + GAM); LAS float* gin = (LAS float*)(lds + GIN); LAS float* rsb = (LAS float*)(lds + RSB); LAS float* rstd = (LAS float*)(lds + RSTD);
    const int cg = tok0 >> 7;
    const int tt = wid >> 1, ss0 = (wid & 1) * 2;
    const bf16_t* kp = KF + ((size_t)(cg * 4 + h) * 4 + ss0) * 8192 + lane * 8;
    const bf16_t* vp = VF + ((size_t)(cg * 4 + h) * 16 + wid * 2) * 4096 + lane * 8;
    const bf16_t* sp = STG + (size_t)(pair * 16 + c) * 131072 + (size_t)wid * 2 * 8192 + lane * 8;
    u32x4 qv[8];
#pragma unroll
    for (int i = 0; i < 8; ++i) { const int it = tid + 512 * i, row = it >> 5, seg = it & 31; qv[i] = __builtin_nontemporal_load((const u32x4*)(Q + (size_t)(tok0 + row) * 1024 + h * 256 + seg * 8)); }
    bf16x8 kk[4][2], bb[4][2];
#pragma unroll
    for (int ks = 0; ks < 4; ++ks) { kk[ks][0] = *(const bf16x8*)(kp + ks * 512); kk[ks][1] = *(const bf16x8*)(kp + 8192 + ks * 512); }
#pragma unroll
    for (int ks = 0; ks < 4; ++ks) ro_loadb(ks, vp, sp, bb[ks]);
    __syncthreads();
    if (tid <= 128) { const double p = dpow_int(1.0 - __builtin_ldexp(1.0, -5 - h), tid); gam[tid] = (float)p; if (tid >= 1) gin[tid - 1] = (float)(1.0 / p); }
    __syncthreads();
#pragma unroll
    for (int i = 0; i < 8; ++i) { const int it = tid + 512 * i, row = it >> 5, seg = it & 31;
        float f[8]; unpack8(qv[i], f); const float gq = gam[row + 1];
#pragma unroll
        for (int e = 0; e < 8; ++e) f[e] *= gq;
        *(LAS u32x4*)(lds + AIM + row * 784 + (128 + seg * 8) * 2) = pack8(f); }
    __syncthreads();
    {
        f32x16 sacc[2];
#pragma unroll
        for (int i = 0; i < 16; ++i) { sacc[0][i] = 0.f; sacc[1][i] = 0.f; }
        if (ss0 <= tt) {
#pragma unroll
            for (int ks = 0; ks < 16; ++ks) {
                const bf16x8 a0 = kk[ks & 3][0], a1 = kk[ks & 3][1];
                if (ks + 4 < 16) { kk[ks & 3][0] = *(const bf16x8*)(kp + (ks + 4) * 512); kk[ks & 3][1] = *(const bf16x8*)(kp + 8192 + (ks + 4) * 512); }
                const bf16x8 bq = *(const LAS bf16x8*)(lds + AIM + (tt * 32 + r) * 784 + (128 + ks * 16 + hh * 8) * 2);
                sacc[0] = MFMA32(a0, bq, sacc[0]); sacc[1] = MFMA32(a1, bq, sacc[1]); }
        }
#pragma unroll
        for (int u = 0; u < 2; ++u)
#pragma unroll
            for (int g = 0; g < 4; ++g) { float pv[4]; const int t = tt * 32 + r;
#pragma unroll
                for (int e = 0; e < 4; ++e) { const int s = (ss0 + u) * 32 + 8 * g + 4 * hh + e; pv[e] = (t >= s) ? sacc[u][4 * g + e] * gin[s] : 0.f; }
                u32x2 pk; pk[0] = cvt_pk_bf16(pv[0], pv[1]); pk[1] = cvt_pk_bf16(pv[2], pv[3]);
                *(LAS u32x2*)(lds + AIM + t * 784 + ((ss0 + u) * 32 + 8 * g + 4 * hh) * 2) = pk; }
    }
    __syncthreads();
    f32x16 acc[4][2];
#pragma unroll
    for (int a = 0; a < 4; ++a)
#pragma unroll
        for (int d = 0; d < 2; ++d)
#pragma unroll
            for (int i = 0; i < 16; ++i) acc[a][d][i] = 0.f;
    if (c > 0) ro_mainloop<24>(acc, bb, vp, sp, lds, r, hh); else ro_mainloop<8>(acc, bb, vp, sp, lds, r, hh);
#pragma unroll
    for (int a = 0; a < 4; ++a) { float q = 0.f;
#pragma unroll
        for (int d = 0; d < 2; ++d)
#pragma unroll
            for (int i = 0; i < 16; ++i) q += acc[a][d][i] * acc[a][d][i];
        q += shx<32>(q);
        if (hh == 0) rsb[(a * 32 + r) * 8 + wid] = q; }
    __syncthreads();
    if (tid < 128) { float s = 0.f;
#pragma unroll
        for (int w = 0; w < 8; ++w) s += rsb[tid * 8 + w];
        rstd[tid] = rsqrtf(s * (1.f / 512.f) + EPSF); }
    __syncthreads();
#pragma unroll
    for (int th = 0; th < 2; ++th) {
#pragma unroll
        for (int ah = 0; ah < 2; ++ah) { const int a = th * 2 + ah; const float rs = rstd[a * 32 + r];
#pragma unroll
            for (int d = 0; d < 2; ++d)
#pragma unroll
                for (int g = 0; g < 4; ++g) { u32x2 pk; pk[0] = cvt_pk_bf16(acc[a][d][4 * g] * rs, acc[a][d][4 * g + 1] * rs); pk[1] = cvt_pk_bf16(acc[a][d][4 * g + 2] * rs, acc[a][d][4 * g + 3] * rs);
                    *(LAS u32x2*)(lds + AIM + (ah * 32 + r) * 1032 + (wid * 64 + d * 32 + 8 * g + 4 * hh) * 2) = pk; } }
        __syncthreads();
#pragma unroll
        for (int i = 0; i < 8; ++i) { const int it = tid + 512 * i, row = it >> 6, seg = it & 63; const size_t tok = (size_t)tok0 + th * 64 + row;
            const u32x2 lo = *(const LAS u32x2*)(lds + AIM + row * 1032 + seg * 16), hi = *(const LAS u32x2*)(lds + AIM + row * 1032 + seg * 16 + 8);
            float o[8], g[8]; unpack8((u32x4){lo[0], lo[1], hi[0], hi[1]}, o); unpack8(__builtin_nontemporal_load((const u32x4*)(SG + tok * 2048 + h * 512 + seg * 8)), g);
#pragma unroll
            for (int e = 0; e < 8; ++e) o[e] *= g[e];
            *(u32x4*)(RO + tok * 3072 + h * 512 + seg * 8) = pack8(o); }
        __syncthreads();
    }
}

DI void retention_sample(const Params& P, ldsp lds, int item, int wb) {
    const int tid = opaque_tid(wb), lane = tid & 63;
    const int bs = item >> 2, h = item & 3; const size_t tok = (size_t)NP + bs;
    const bf16_t* Q = (const bf16_t*)(P.ws + OFF_Q); const bf16_t* Kk = (const bf16_t*)(P.ws + OFF_K); const bf16_t* VT = (const bf16_t*)(P.ws + OFF_VT);
    const bf16_t* SG = (const bf16_t*)(P.ws + OFF_SG); bf16_t* RO = (bf16_t*)(P.ws + OFF_RO);
    LAS float* QF = (LAS float*)lds; LAS float* KF = QF + 256; LAS float* VF = QF + 512; LAS float* RED = QF + 1024;
    __syncthreads();
    if (tid < 256) { QF[tid] = bf2f(Q[tok * 1024 + h * 256 + tid]); KF[tid] = bf2f(Kk[kf_idx((int)tok, h, tid)]); }
    VF[tid] = bf2f(VT[vf_idx((int)tok, h, tid)]);
    __syncthreads();
    float qk = 0.f;
#pragma unroll
    for (int i = 0; i < 4; ++i) qk += QF[lane + 64 * i] * KF[lane + 64 * i];
    qk = sum_x63(qk);
    const float gamma = 1.f - __builtin_ldexpf(1.f, -5 - h);
    const int dv4 = (tid & 127) * 4, kg = tid >> 7;
    const size_t sb = ((size_t)(bs * 4 + h) * 256 + kg * 64) * 512 + dv4;
    const f32x4* S0 = (const f32x4*)(P.in[2] + sb); f32x4* S1 = (f32x4*)(P.out + OUT_SS + sb);
    const f32x4 v4 = *(const LAS f32x4*)(VF + dv4);
    f32x4 a4 = (f32x4){0.f, 0.f, 0.f, 0.f};
    for (int i0 = 0; i0 < 64; i0 += 32) {
        f32x4 s[32];
#pragma unroll
        for (int i = 0; i < 32; ++i) s[i] = __builtin_nontemporal_load(S0 + (size_t)(i0 + i) * 128);
#pragma unroll
        for (int i = 0; i < 32; ++i) { const float q = QF[kg * 64 + i0 + i], k = KF[kg * 64 + i0 + i];
            a4 += q * s[i];
            __builtin_nontemporal_store(gamma * s[i] + k * v4, S1 + (size_t)(i0 + i) * 128); }
    }
    *(LAS f32x4*)(RED + kg * 512 + dv4) = a4;
    __syncthreads();
    const float qs = RED[tid] + RED[512 + tid] + RED[1024 + tid] + RED[1536 + tid];
    const float o = qk * VF[tid] + gamma * qs;
    float q2 = o * o;
    q2 = sum_x63(q2);
    __syncthreads();
    if (lane == 0) RED[tid >> 6] = q2;
    __syncthreads();
    float tot = 0.f;
#pragma unroll
    for (int w = 0; w < 8; ++w) tot += RED[w];
    const float rs = rsqrtf(tot * (1.f / 512.f) + EPSF);
    RO[tok * 3072 + h * 512 + tid] = f2bf(bf2f(SG[tok * 2048 + h * 512 + tid]) * o * rs);
}

DI void gmlp_prompt(const Params& P, ldsp lds, int item, int wb) {
    const int tid = opaque_tid(wb), wid = tid >> 6, lane = tid & 63, r = lane & 31, hh = lane >> 5;
    const int b = item >> 6, c = (item >> 2) & 15, g = item & 3;
    int tok0 = b * 2048 + c * 128; asm volatile("" : "+s"(tok0));
    constexpr int WS_ = 0, GV = 34816, MU = 104448, RS = 104960;
    const bf16_t* GVT = (const bf16_t*)(P.ws + OFF_GVT); const bf16_t* GU = (const bf16_t*)(P.ws + OFF_GU); bf16_t* GI = (bf16_t*)(P.ws + OFF_RO);
    const float* st = (const float*)(P.ws + OFF_ST); const float* lnsum = st + (size_t)MP * 4; const float* lnsq = st + (size_t)MP * 5;
    LAS float* mu = (LAS float*)(lds + MU); LAS float* rs = (LAS float*)(lds + RS);
    float s1 = 0.f, s2 = 0.f;
    if (tid < 128) { s1 = lnsum[tok0 + tid]; s2 = lnsq[tok0 + tid]; }
    u32x4 xg[8];
#pragma unroll
    for (int i = 0; i < 8; ++i) { const int it = tid + 512 * i, row = it >> 4, seg = it & 15; xg[i] = __builtin_nontemporal_load((const u32x4*)(GVT + (size_t)(g * 256 + row) * MP + tok0 + seg * 8)); }
    f32x4 wv[4][2];
    { const float* W = P.in[8] + (size_t)g * 16384;
#pragma unroll
      for (int i = 0; i < 4; ++i) { const int it = tid + 512 * i, t = it >> 4, seg = it & 15; wv[i][0] = *(const f32x4*)(W + t * 128 + seg * 8); wv[i][1] = *(const f32x4*)(W + t * 128 + seg * 8 + 4); } }
    __syncthreads();
    if (tid < 128) { const float m = s1 * (1.f / 1024.f); const float var = fmaxf(s2 * (1.f / 1024.f) - m * m, 0.f); mu[tid] = m; rs[tid] = rsqrtf(var + EPSF); }
#pragma unroll
    for (int i = 0; i < 4; ++i) { const int it = tid + 512 * i, t = it >> 4, seg = it & 15;
        float v[8] = {wv[i][0][0], wv[i][0][1], wv[i][0][2], wv[i][0][3], wv[i][1][0], wv[i][1][1], wv[i][1][2], wv[i][1][3]};
#pragma unroll
        for (int e = 0; e < 8; ++e) v[e] = (seg * 8 + e <= t) ? v[e] : 0.f;
        *(LAS u32x4*)(lds + WS_ + t * 272 + seg * 16) = pack8(v); }
    __syncthreads();
    { const float* lg = P.in[6] + g * 256; const float* lb = P.in[7] + g * 256;
#pragma unroll
      for (int i = 0; i < 8; ++i) { const int it = tid + 512 * i, row = it >> 4, seg = it & 15;
          float v[8]; unpack8(xg[i], v); const float a = lg[row], bb = lb[row];
#pragma unroll
          for (int e = 0; e < 8; ++e) v[e] = (v[e] - mu[seg * 8 + e]) * rs[seg * 8 + e] * a + bb;
          *(LAS u32x4*)(lds + GV + row * 272 + seg * 16) = pack8(v); } }
    __syncthreads();
    const int tt = wid & 3, cb = (wid >> 2) * 4;
    f32x16 acc[4];
#pragma unroll
    for (int u = 0; u < 4; ++u)
#pragma unroll
        for (int i = 0; i < 16; ++i) acc[u][i] = 0.f;
    for (int ks = 0; ks < 2 * (tt + 1); ++ks) { const int ko = (ks * 16 + hh * 8) * 2;
        const bf16x8 a = *(const LAS bf16x8*)(lds + WS_ + (tt * 32 + r) * 272 + ko);
#pragma unroll
        for (int u = 0; u < 4; ++u) { const bf16x8 bv = *(const LAS bf16x8*)(lds + GV + ((cb + u) * 32 + r) * 272 + ko); acc[u] = MFMA32(bv, a, acc[u]); } }
    const int tl = tt * 32 + r; const size_t tok = (size_t)tok0 + tl; const float bi = P.in[9][g * 128 + tl];
#pragma unroll
    for (int u = 0; u < 4; ++u)
#pragma unroll
        for (int q = 0; q < 4; ++q) { const int ch = g * 256 + (cb + u) * 32 + 8 * q + 4 * hh;
            const u32x2 gu = *(const u32x2*)(GU + tok * 1024 + ch);
            u32x2 o; o[0] = cvt_pk_bf16(bf_lo(gu[0]) * (acc[u][4 * q] + bi), bf_hi(gu[0]) * (acc[u][4 * q + 1] + bi));
            o[1] = cvt_pk_bf16(bf_lo(gu[1]) * (acc[u][4 * q + 2] + bi), bf_hi(gu[1]) * (acc[u][4 * q + 3] + bi));
            *(u32x2*)(GI + tok * 3072 + 2048 + ch) = o; }
}
DI void gmlp_sample(const Params& P, int wb) {
    const bf16_t* GVT = (const bf16_t*)(P.ws + OFF_GVT); const bf16_t* GU = (const bf16_t*)(P.ws + OFF_GU); bf16_t* GI = (bf16_t*)(P.ws + OFF_RO);
    const float* st = (const float*)(P.ws + OFF_ST); const float* lnsum = st + (size_t)MP * 4; const float* lnsq = st + (size_t)MP * 5;
    for (size_t i = (size_t)blockIdx.x * 512 + opaque_tid(wb); i < (size_t)NSAMP * 1024; i += (size_t)gridDim.x * 512) {
        const int bs = (int)(i >> 10), ch = (int)(i & 1023), g = ch >> 8; const size_t tok = (size_t)NP + bs;
        const float m = lnsum[tok] * (1.f / 1024.f), var = fmaxf(lnsq[tok] * (1.f / 1024.f) - m * m, 0.f), rstd = rsqrtf(var + EPSF);
        const float x = bf2f(GVT[(size_t)ch * MP + tok]);
        const float gvn = (x - m) * rstd * P.in[6][ch] + P.in[7][ch];
        P.out[OUT_GV + i] = gvn;
        const float mixed = P.in[8][(size_t)g * 16384] * gvn + P.in[9][g * 128];
        GI[tok * 3072 + 2048 + ch] = f2bf(bf2f(GU[tok * 1024 + ch]) * mixed);
    }
}

DI void fixup_merge(const Params& P, int wb) {
    const bf16_t* AR = (const bf16_t*)(P.ws + OFF_AR); const bf16_t* AG = (const bf16_t*)(P.ws + OFF_AG); bf16_t* MM = (bf16_t*)(P.ws + OFF_MM);
    const float* ar = (const float*)(P.ws + OFF_ACC); const float* ag = ar + 8 * 131072;
    for (size_t i = (size_t)blockIdx.x * 512 + opaque_tid(wb); i < (size_t)NSAMP * 1024; i += (size_t)gridDim.x * 512) {
        const size_t gi = (size_t)NP * 1024 + i;
        float sr = 0.f, sg = 0.f;
#pragma unroll
        for (int k = 0; k < 8; ++k) sr += ar[(size_t)k * 131072 + i];
#pragma unroll
        for (int k = 0; k < 4; ++k) sg += ag[(size_t)k * 131072 + i];
        MM[gi] = f2bf(bf2f(AR[gi]) * sr + bf2f(AG[gi]) * sg); }
}
DI void fixup_o(const Params& P, int wb) {
    const int tid = opaque_tid(wb), lane = tid & 63, gw = blockIdx.x * 8 + (tid >> 6);
    if (gw >= NSAMP) return;
    const float* ao = (const float*)(P.ws + OFF_ACC) + 12 * 131072 + (size_t)gw * 1024 + lane * 16;
    const float* xr = P.in[1] + (size_t)gw * 1024 + lane * 16;
    float* H = (float*)(P.ws + OFF_H) + (size_t)(NP + gw) * 1024 + lane * 16; bf16_t* HB = (bf16_t*)(P.ws + OFF_HB) + (size_t)(NP + gw) * 1024 + lane * 16;
    float v[16], ss = 0.f;
#pragma unroll
    for (int i = 0; i < 4; ++i) { f32x4 a = *(const f32x4*)(ao + 4 * i); const f32x4 x = *(const f32x4*)(xr + 4 * i);
#pragma unroll
        for (int k = 1; k < 4; ++k) a += *(const f32x4*)(ao + (size_t)k * 131072 + 4 * i);
#pragma unroll
        for (int e = 0; e < 4; ++e) { v[4 * i + e] = a[e] + x[e]; ss += v[4 * i + e] * v[4 * i + e]; }
        *(f32x4*)(H + 4 * i) = (f32x4){v[4 * i], v[4 * i + 1], v[4 * i + 2], v[4 * i + 3]}; }
    *(u32x4*)HB = pack8(v); *(u32x4*)(HB + 8) = pack8(v + 8);
    ss = sum_x63(ss);
    if (lane == 0) ((float*)(P.ws + OFF_ST))[(size_t)MP * 6 + NP + gw] = ss;
}
DI void final_norm(const Params& P, int wb) {
    const float* ss2 = (const float*)(P.ws + OFF_ST) + (size_t)MP * 7; const float* g = P.in[15];
    const int tid = opaque_tid(wb);
    const bf16_t* Y2 = (const bf16_t*)(P.ws + OFF_T1);
    for (size_t i = (size_t)blockIdx.x * 512 + tid; i < (size_t)NP * 128; i += (size_t)gridDim.x * 512) {
        const int row = (int)(i >> 7), c8 = (int)(i & 127) * 8;
        const float rs = rsqrtf(ss2[row] * (1.f / 1024.f) + EPSF);
        float v[8]; unpack8(__builtin_nontemporal_load((const u32x4*)(Y2 + (size_t)row * 1024 + c8)), v);
        const f32x4 g0 = *(const f32x4*)(g + c8), g1 = *(const f32x4*)(g + c8 + 4);
        *(f32x4*)(P.out + OUT_Y + (size_t)row * 1024 + c8) = (f32x4){v[0] * rs * g0[0], v[1] * rs * g0[1], v[2] * rs * g0[2], v[3] * rs * g0[3]};
        *(f32x4*)(P.out + OUT_Y + (size_t)row * 1024 + c8 + 4) = (f32x4){v[4] * rs * g1[0], v[5] * rs * g1[1], v[6] * rs * g1[2], v[7] * rs * g1[3]};
    }
    const int lane = tid & 63, gw = blockIdx.x * 8 + (tid >> 6);
    if (gw < NSAMP) {
        const float* af = (const float*)(P.ws + OFF_ACC) + 16 * 131072 + (size_t)gw * 1024 + lane * 16;
        const float* H = (const float*)(P.ws + OFF_H) + (size_t)(NP + gw) * 1024 + lane * 16;
        float v[16], ss = 0.f;
#pragma unroll
        for (int i = 0; i < 4; ++i) { f32x4 a = *(const f32x4*)(af + 4 * i); const f32x4 x = *(const f32x4*)(H + 4 * i);
#pragma unroll
            for (int k = 1; k < 11; ++k) a += *(const f32x4*)(af + (size_t)k * 131072 + 4 * i);
#pragma unroll
            for (int e = 0; e < 4; ++e) { v[4 * i + e] = a[e] + x[e]; ss += v[4 * i + e] * v[4 * i + e]; } }
        ss = sum_x63(ss);
        const float rs = rsqrtf(ss * (1.f / 1024.f) + EPSF);
        float* y = P.out + OUT_Y + (size_t)(NP + gw) * 1024 + lane * 16;
#pragma unroll
        for (int i = 0; i < 4; ++i) { const f32x4 gg = *(const f32x4*)(g + lane * 16 + 4 * i);
            *(f32x4*)(y + 4 * i) = (f32x4){v[4 * i] * rs * gg[0], v[4 * i + 1] * rs * gg[1], v[4 * i + 2] * rs * gg[2], v[4 * i + 3] * rs * gg[3]}; }
    }
}

#define XB_TMO      128
#define XB_XCNT(j)  (256  + 64 * (j))
#define XB_XSUB(j)  (1280 + 64 * (j))
#define XB_XGEN(j)  (2304 + 64 * (j))
#define XB_TOP      3328
#define XB_TOPGEN   3392
#define XCD_BAR_WORDS 3456
#define XB_SPIN_CAP (1u << 22)
DI unsigned xb_ld(unsigned* p)              { return __hip_atomic_load(p, __ATOMIC_RELAXED, __HIP_MEMORY_SCOPE_AGENT); }
DI unsigned xb_add(unsigned* p, unsigned v) { return __hip_atomic_fetch_add(p, v, __ATOMIC_RELAXED, __HIP_MEMORY_SCOPE_AGENT); }
DI unsigned xb_xcc_id() { return (unsigned)__builtin_amdgcn_s_getreg((3 << 11) | 20) & 0xFu; }
#define XB_SPIN(cond, bar) do { unsigned _sp = 0; while (cond) { __builtin_amdgcn_s_sleep(1); \
    if ((++_sp & 255u) == 0u) { if (xb_ld(&(bar)[XB_TMO])) break; if (_sp > XB_SPIN_CAP) { atomicAdd(&(bar)[XB_TMO], 1u); break; } } } } while (0)
struct XcdBarrier { unsigned* bar; unsigned x; volatile LAS unsigned* st; };
DI XcdBarrier xcd_barrier_post(unsigned* bar, volatile LAS unsigned* st, int wb) {
    XcdBarrier b; b.bar = bar; b.x = xb_xcc_id(); b.st = st;
    if (opaque_tid(wb) == 0) (void)xb_add(&bar[XB_XCNT(b.x)], 1u);
    return b;
}
DI void xcd_barrier_complete(unsigned* bar, unsigned x, unsigned& nloc, unsigned& nx) {
    const unsigned G = gridDim.x * gridDim.y * gridDim.z;
    unsigned sum, cnt, mine, sp = 0u;
    for (;;) {
        sum = 0u; cnt = 0u; mine = 0u;
#pragma unroll
        for (unsigned j = 0; j < 16; ++j) { const unsigned c = xb_ld(&bar[XB_XCNT(j)]); sum += c; cnt += (c > 0u) ? 1u : 0u; mine = (j == x) ? c : mine; }
        if (sum == G) break;
        __builtin_amdgcn_s_sleep(1);
        if ((++sp & 255u) == 0u) { if (xb_ld(&bar[XB_TMO])) break; if (sp > XB_SPIN_CAP) { atomicAdd(&bar[XB_TMO], 1u); break; } }
    }
    nloc = mine > 0u ? mine : 1u; nx = cnt > 0u ? cnt : 1u;
}
DI void xcd_barrier(const XcdBarrier& b, int wb) {
    asm volatile("s_waitcnt vmcnt(0)" ::: "memory");
    __syncthreads();
    if (opaque_tid(wb) == 0) {
        unsigned* bar = b.bar;
        __builtin_amdgcn_s_waitcnt(0);
        unsigned nloc = b.st[0], nx = b.st[1];
        if (nloc == 0u) { xcd_barrier_complete(bar, b.x, nloc, nx); b.st[0] = nloc; b.st[1] = nx; }
        const unsigned old = xb_add(&bar[XB_XSUB(b.x)], 1u);
        const unsigned gen = old / nloc;
        if (old + 1u == (gen + 1u) * nloc) {
            __builtin_amdgcn_fence(__ATOMIC_RELEASE, "agent");
            asm volatile("s_waitcnt vmcnt(0)" ::: "memory");
            const unsigned og = xb_add(&bar[XB_TOP], 1u);
            const unsigned tg = og / nx;
            if (og + 1u == (tg + 1u) * nx) xb_add(&bar[XB_TOPGEN], 1u);
            else XB_SPIN(xb_ld(&bar[XB_TOPGEN]) == tg, bar);
            __builtin_amdgcn_fence(__ATOMIC_ACQUIRE, "agent");
            xb_add(&bar[XB_XGEN(b.x)], 1u);
            asm volatile("s_waitcnt vmcnt(0)" ::: "memory");
        } else {
            XB_SPIN(xb_ld(&bar[XB_XGEN(b.x)]) == gen, bar);
            __builtin_amdgcn_fence(__ATOMIC_ACQUIRE, "agent");
            asm volatile("s_waitcnt vmcnt(0)" ::: "memory");
        }
    }
    __syncthreads();
}

__global__ void __launch_bounds__(512, 2) fwd_megakernel(Params P) {
    extern __shared__ __attribute__((aligned(16))) unsigned char shm[];
    ldsp lds = (ldsp)shm;
    cg::grid_group grid = cg::this_grid();
    const int G = gridDim.x, c = blockIdx.x;
    unsigned char* ws = P.ws;
#define RELAUNDER() asm volatile("" : "+s"(ws))
    float* st = (float*)(ws + OFF_ST);
    float* sso = st; float* lnsum = st + (size_t)MP * 4; float* lnsq = st + (size_t)MP * 5; float* ssh = st + (size_t)MP * 6; float* ssh2 = st + (size_t)MP * 7;
    const float* rope = (const float*)(ws + OFF_ROPE);
    const int wb = __builtin_amdgcn_readfirstlane((int)threadIdx.x);
    volatile LAS unsigned* bst = (volatile LAS unsigned*)(lds + LDS_BYTES - 16);
    { const int t = opaque_tid(wb); if (t < 2) bst[t] = 0u; }
    __syncthreads();
    const XcdBarrier xb = xcd_barrier_post((unsigned*)(ws + OFF_BAR), bst, wb);
#ifndef PROBE_MASK
#define PROBE_MASK 0
#endif
#ifndef PROBE_K
#define PROBE_K 4
#endif
    unsigned long long tp_acc = 0ull, tp0 = 0ull;
#define PH_BEGIN(k) do { if (PROBE_MASK & (1 << (k))) tp0 = __builtin_amdgcn_s_memrealtime(); } while (0)
#define PH_END(k) do { if (PROBE_MASK & (1 << (k))) tp_acc += __builtin_amdgcn_s_memrealtime() - tp0; } while (0)

    PH_BEGIN(0);
    phase0(P, lds, wb);
    if (P.ws == nullptr) grid.sync();
    xcd_barrier(xb, wb);
    PH_END(0); PH_BEGIN(1);
    {
        pg8::Gemm g1{(const bf16_t*)(ws + OFF_XN), (const bf16_t*)(ws + OFF_WT1), MP, 6144, 1024, 1024, 1024};
        pg8::Order s1; s1.init(MP, 6144, G, c);
        EpiIn1 e1{ws, rope};
        pg8::gemm_phase(lds, g1, s1, e1, wb);
        pg8::Gemm g2{(const bf16_t*)(ws + OFF_WT2), (const bf16_t*)(ws + OFF_XN), 4096, MP, 1024, 1024, 1024};
        pg8::Order s2; s2.init(4096, MP, G, (c + G - (s1.nwg % G)) % G);
        EpiIn2 e2{(bf16_t*)(ws + OFF_KT), (bf16_t*)(ws + OFF_VT), (bf16_t*)(ws + OFF_GVT), (bf16_t*)(ws + OFF_K), rope, lnsum, lnsq};
        pg8::gemm_phase(lds, g2, s2, e2, wb);
        const int n1 = s1.nwg % G, n2 = s2.nwg % G;
        if (n1 + n2 < G) { if (c >= n1 + n2) wjobs(P, lds, opaque_tid(wb), 640 + (c - n1 - n2), G - n1 - n2, 1424); }
        else wjobs(P, lds, opaque_tid(wb), 640 + c, G, 1424);
    }
    xcd_barrier(xb, wb);
    PH_END(1); PH_BEGIN(2);
    if (G == 256) {
        if (c < 128) { retention_scan(P, lds, c, wb); retention_scan(P, lds, c + 128, wb); }
        else { for (int item = c - 128; item < 512; item += 128) retention_sample(P, lds, item, wb); }
    } else {
        for (int item = c; item < 512; item += G) retention_sample(P, lds, item, wb);
        for (int item = c; item < 256; item += G) retention_scan(P, lds, item, wb);
    }
    {
        unsigned* q = (unsigned*)(ws + OFF_BAR) + XCD_BAR_WORDS + 16;
        LAS unsigned* tk = (LAS unsigned*)(lds + LDS_BYTES - 32);
        for (;;) {
            __syncthreads();
            if (opaque_tid(wb) == 0) tk[0] = __hip_atomic_fetch_add(q, 1u, __ATOMIC_RELAXED, __HIP_MEMORY_SCOPE_AGENT);
            __syncthreads();
            const int item = (int)tk[0];
            if (item >= 512) break;
            gmlp_prompt(P, lds, item, wb);
        }
    }
    gmlp_sample(P, wb);
    xcd_barrier(xb, wb);
    PH_END(2); PH_BEGIN(11);
    for (int item = c; item < 512; item += G) retention_out(P, lds, item, wb);
    {
        pg8::SplitOrder sr; sr.init(64, 12, G, c);
        pg8::Gemm g3{(const bf16_t*)(ws + OFF_RO), (const bf16_t*)(ws + OFF_WRET), MP, 1024, 256, 3072, 3072};
        EpiSplit e3{(float*)(ws + OFF_ACC)};
        pg8::gemm_phase(lds, g3, sr, e3, wb);
    }
    xcd_barrier(xb, wb);
    PH_END(11); PH_BEGIN(3);
    fixup_merge(P, wb);
    {
        pg8::Order s; s.init(NP, 1024, G, c);
        pg8::Gemm g1{(const bf16_t*)(ws + OFF_RO), (const bf16_t*)(ws + OFF_WRET), NP, 1024, 3072, 3072, 3072};
        EpiMerge e1{(const bf16_t*)(ws + OFF_AR), (const bf16_t*)(ws + OFF_AG), (bf16_t*)(ws + OFF_MM)};
        pg8::gemm_phase(lds, g1, s, e1, wb);
    }
    xcd_barrier(xb, wb);
    PH_END(3); PH_BEGIN(4);
    {
        pg8::Order s; s.init(NP, 1024, G, c);
        pg8::Gemm g{(const bf16_t*)(ws + OFF_MM), (const bf16_t*)(ws + OFF_WO), NP, 1024, 1024, 1024, 1024};
        EpiO e{P.in[0], P.in[1], (float*)(ws + OFF_H), (bf16_t*)(ws + OFF_HB), ssh};
        pg8::gemm_phase(lds, g, s, e, wb);
        pg8::SplitOrder so; so.init(64, 4, G, c);
        pg8::Gemm g2{(const bf16_t*)(ws + OFF_MM), (const bf16_t*)(ws + OFF_WO), MP, 1024, 256, 1024, 1024};
        EpiSplit e2{(float*)(ws + OFF_ACC) + 12 * 131072};
        pg8::gemm_phase(lds, g2, so, e2, wb);
    }
    xcd_barrier(xb, wb);
    fixup_o(P, wb);
    xcd_barrier(xb, wb);
    PH_END(4); PH_BEGIN(5);
    {
        pg8::Order s; s.init(MP, 5632, G, c);
        pg8::Gemm g{(const bf16_t*)(ws + OFF_HB), (const bf16_t*)(ws + OFF_WF1), MP, 5632, 1024, 1024, 1024};
        EpiF1 e{ssh, (bf16_t*)(ws + OFF_ACT)};
        pg8::gemm_phase(lds, g, s, e, wb);
    }
    xcd_barrier(xb, wb);
    PH_END(5); PH_BEGIN(6);
    {
        pg8::Order s; s.init(NP, 1024, G, c);
        pg8::Gemm g{(const bf16_t*)(ws + OFF_ACT), (const bf16_t*)(ws + OFF_WF2), NP, 1024, 2816, 2816, 2816};
        EpiF2 e{(const bf16_t*)(ws + OFF_HB), (bf16_t*)(ws + OFF_T1), ssh2};
        pg8::gemm_phase(lds, g, s, e, wb);
        pg8::SplitOrder sf; sf.init(64, 11, G, c);
        pg8::Gemm g2{(const bf16_t*)(ws + OFF_ACT), (const bf16_t*)(ws + OFF_WF2), MP, 1024, 256, 2816, 2816};
        EpiSplit e2{(float*)(ws + OFF_ACC) + 16 * 131072};
        pg8::gemm_phase(lds, g2, sf, e2, wb);
    }
    xcd_barrier(xb, wb);
    PH_END(6); PH_BEGIN(7);
    final_norm(P, wb);
    PH_END(7);
    if (PROBE_MASK != 0 && blockIdx.x == 0) {
        __syncthreads();
        const unsigned long long t_end = __builtin_amdgcn_s_memrealtime() + (unsigned long long)PROBE_K * tp_acc;
        while (__builtin_amdgcn_s_memrealtime() < t_end) __builtin_amdgcn_s_sleep(8);
    }
}

extern "C" void kernel_launch(void* const* d_in, const int* in_sizes, int n_in, void* d_out, int out_size, void* d_ws, size_t ws_size, hipStream_t stream) {
    static int grid_blocks = 0;
    if (!grid_blocks) {
        int dev = 0, cus = 0, per_cu = 0;
        (void)hipGetDevice(&dev);
        (void)hipDeviceGetAttribute(&cus, hipDeviceAttributeMultiprocessorCount, dev);
        (void)hipFuncSetAttribute((const void*)fwd_megakernel, hipFuncAttributeMaxDynamicSharedMemorySize, LDS_BYTES);
        (void)hipOccupancyMaxActiveBlocksPerMultiprocessor(&per_cu, (const void*)fwd_megakernel, 512, LDS_BYTES);
        if (per_cu < 1) per_cu = 1;
        if (cus < 1) cus = 256;
        grid_blocks = cus * per_cu;
        if (ws_size < WS_END) fprintf(stderr, "kernel_launch: workspace too small: %zu < %zu\n", ws_size, (size_t)WS_END);
    }
    Params p{};
    for (int i = 0; i < 16; ++i) p.in[i] = (const float*)d_in[i];
    p.out = (float*)d_out; p.ws = (unsigned char*)d_ws;
    (void)hipMemsetAsync((unsigned char*)d_ws + OFF_BAR, 0, 16384, stream);
    void* args[] = {&p};
    hipError_t e = hipLaunchCooperativeKernel((const void*)fwd_megakernel, dim3(grid_blocks), dim3(512), args, LDS_BYTES, stream);
    if (e != hipSuccess) fprintf(stderr, "cooperative launch failed: %s (grid %d)\n", hipGetErrorString(e), grid_blocks);
}
```
